# Optimizing an MI355X kernel written in HIP

```python
import math
import jax, jax.numpy as jnp
from jax import lax
import numpy as np

D_MODEL = 2048
BATCH = 2
SEQ = 4096
DEPTH = 2

RWKV_HEAD_DIM = 64
RWKV_WIDTH = D_MODEL // 2
RWKV_HEADS = RWKV_WIDTH // RWKV_HEAD_DIM
DECAY_LORA = 64
ICLR_LORA = 64
VRES_LORA = 32
GATE_LORA = 160
LNX_EPS = 64e-5

ATTN_GROUPS = ((128, 1), (512, 4), (2048, 16))
ATTN_HEADS_PER_GROUP = 4
ATTN_HEAD_DIM = D_MODEL // 16
ATTN_HEADS = len(ATTN_GROUPS) * ATTN_HEADS_PER_GROUP
ATTN_OUT_WIDTH = ATTN_HEADS_PER_GROUP * ATTN_HEAD_DIM

SGU_CHUNK = 128
SGU_GROUPS = 4
SGU_WIDTH = D_MODEL // 4
SGU_GROUP_DIM = SGU_WIDTH // SGU_GROUPS

FFN_DIM = ((8 * D_MODEL // 3 + 127) // 128) * 128
RMS_EPS = 1e-6
LN_EPS = 1e-5
N_BRANCHES = 3

N_SHIFT = 3 * RWKV_WIDTH + DECAY_LORA + ICLR_LORA + GATE_LORA
N_QKV = 3 * ATTN_HEADS * ATTN_HEAD_DIM
N_SGU = 2 * SGU_WIDTH
N_GATE = N_BRANCHES * D_MODEL
N_IN = N_SHIFT + N_QKV + N_SGU + N_GATE

kernel_name = "hybrid_rwkv7_dilated_alibi_sgu_macaron"


def rms_norm(x, g):
    xf = x.astype(jnp.float32)
    y = xf * lax.rsqrt(jnp.mean(xf * xf, axis=-1, keepdims=True) + RMS_EPS)
    return (y * g.astype(jnp.float32)).astype(x.dtype)


def token_shift(p):
    return jnp.pad(p, ((0, 0), (1, 0), (0, 0)))[:, :-1]


def swiglu_ffn(x, w_gu, w_down):
    gate, up = jnp.split(x @ w_gu, 2, axis=-1)
    return (jax.nn.silu(gate) * up) @ w_down


def alibi_slopes(n_heads):
    def geometric(n):
        start = 2.0 ** (-8.0 / n)
        return [start ** (i + 1) for i in range(n)]
    closest = 2 ** int(math.floor(math.log2(n_heads)))
    slopes = geometric(closest)
    if closest < n_heads:
        slopes += geometric(2 * closest)[0::2][: n_heads - closest]
    return np.array(sorted(slopes, reverse=True), dtype=np.float32)


def wkv7_scan(r, w, k, v, a, b):
    B, T, H, N = r.shape

    def step(S, inp):
        r_t, w_t, k_t, v_t, a_t, b_t = inp
        sa = jnp.einsum('bhij,bhj->bhi', S, a_t)
        S = (S * w_t[:, :, None, :] + sa[:, :, :, None] * b_t[:, :, None, :]
             + v_t[:, :, :, None] * k_t[:, :, None, :])
        return S, jnp.einsum('bhij,bhj->bhi', S, r_t)

    S0 = jnp.zeros((B, H, N, N), jnp.float32)
    xs = tuple(jnp.moveaxis(z, 1, 0) for z in (r, w, k, v, a, b))
    _, ys = lax.scan(step, S0, xs)
    return jnp.moveaxis(ys, 0, 1)


def rwkv7_time_mix(xr, xk, v, xw, xa, xg, decay_w0, decay_w2, iclr_a0, iclr_a2, gate_g2,
                   k_k, k_a, r_k, lnx_w, lnx_b):
    B, T, _ = xr.shape
    H, N = RWKV_HEADS, RWKV_HEAD_DIM
    f32 = jnp.float32
    heads = lambda z: z.astype(f32).reshape(B, T, H, N)
    w_log = -jax.nn.softplus(-(decay_w0 + jnp.tanh(xw) @ decay_w2).astype(f32)) - 0.5
    decay = jnp.exp(-jnp.exp(w_log))
    a = jax.nn.sigmoid((iclr_a0 + xa @ iclr_a2).astype(f32))
    g = jax.nn.sigmoid(xg) @ gate_g2
    k = xk.astype(f32)
    kk = heads(k * k_k)
    kk = kk / jnp.maximum(jnp.linalg.norm(kk, axis=-1, keepdims=True), 1e-12)
    k = k * (1.0 + (a - 1.0) * k_a)
    r_h, k_h, v_h, a_h = heads(xr), heads(k), heads(v), heads(a)
    y = wkv7_scan(r_h, heads(decay), k_h, v_h, -kk, kk * a_h)
    mu = jnp.mean(y, axis=-1, keepdims=True)
    var = jnp.mean(jnp.square(y - mu), axis=-1, keepdims=True)
    y = ((y - mu) * lax.rsqrt(var + LNX_EPS)).reshape(B, T, H * N) * lnx_w + lnx_b
    bonus = jnp.sum(r_h * k_h * r_k, axis=-1, keepdims=True) * v_h
    y = (y + bonus.reshape(B, T, H * N)) * g
    return y.astype(xr.dtype)


def dilated_attention_group(q, k, v, window, dilation, slopes):
    B, T, Hg, E = q.shape
    blk = window // dilation
    span = blk * dilation
    t_pad = -(-T // span) * span
    L = t_pad // dilation
    nb = L // blk

    def to_sub(z):
        z = jnp.pad(z, ((0, 0), (0, t_pad - T), (0, 0), (0, 0)))
        z = z.reshape(B, L, dilation, Hg, E).transpose(0, 2, 3, 1, 4)
        return z.reshape(B, dilation, Hg, nb, blk, E)

    def with_prev(z):
        prev = jnp.pad(z, ((0, 0), (0, 0), (0, 0), (1, 0), (0, 0), (0, 0)))[:, :, :, :-1]
        return jnp.concatenate([prev, z], axis=4)

    qs = to_sub(q)
    kc, vc = with_prev(to_sub(k)), with_prev(to_sub(v))
    s = jnp.einsum('brhnqe,brhnke->brhnqk', qs, kc).astype(jnp.float32) * (E ** -0.5)
    i = jnp.arange(blk)[:, None]
    j = jnp.arange(2 * blk)[None, :]
    rel = blk + i - j
    blk_idx = jnp.arange(nb)[:, None, None]
    mask = (rel >= 0) & (rel <= blk) & ((blk_idx > 0) | (j >= blk))
    dist = (rel * dilation).astype(jnp.float32)
    bias = -slopes[:, None, None] * dist
    s = jnp.where(mask, s + bias[None, None, :, None], -jnp.inf)
    lse = jax.nn.logsumexp(s, axis=-1)
    p = jnp.exp(s - lse[..., None])
    o = jnp.einsum('brhnqk,brhnke->brhnqe', p.astype(v.dtype), vc)
    o = o.reshape(B, dilation, Hg, L, E).transpose(0, 3, 1, 2, 4).reshape(B, t_pad, Hg, E)[:, :T]
    lse = lse.reshape(B, dilation, Hg, L).transpose(0, 3, 1, 2).reshape(B, t_pad, Hg)[:, :T]
    return o, lse


def spatial_gating(u, v, ln_g, ln_b, w_s, b_s):
    B, T, C = v.shape
    vf = v.astype(jnp.float32)
    mu = jnp.mean(vf, axis=-1, keepdims=True)
    var = jnp.mean(jnp.square(vf - mu), axis=-1, keepdims=True)
    vn = ((vf - mu) * lax.rsqrt(var + LN_EPS) * ln_g + ln_b).astype(v.dtype)
    vn = vn.reshape(B, T // SGU_CHUNK, SGU_CHUNK, SGU_GROUPS, SGU_GROUP_DIM)
    causal = jnp.tril(jnp.ones((SGU_CHUNK, SGU_CHUNK), dtype=bool))
    w = jnp.where(causal, w_s, jnp.zeros_like(w_s))
    mixed = jnp.einsum('gts,bcsgd->bctgd', w, vn) + b_s.T[:, :, None]
    return u * mixed.reshape(B, T, C)


def setup_inputs(seed: int = 0) -> dict:
    key = jax.random.key(seed)
    ks = iter(jax.random.split(key, 48))
    L, D, F, W = DEPTH, D_MODEL, FFN_DIM, RWKV_WIDTH

    def normal(shape, scale):
        return jax.random.normal(next(ks), shape, jnp.float32) * scale

    def uniform(shape, lo, hi):
        return jax.random.uniform(next(ks), shape, jnp.float32, lo, hi)

    def gain(shape):
        return 1.0 + normal(shape, 0.02)

    return {
        "x": normal((BATCH, SEQ, D), 1.0),
        "ffn1_pre_g": gain((L, D)),
        "ffn1_w_gu": normal((L, D, 2 * F), D ** -0.5),
        "ffn1_w_down": normal((L, F, D), F ** -0.5),
        "ffn1_post_g": gain((L, D)),
        "mix_pre_g": gain((L, D)),
        "w_in": normal((L, D, N_IN), D ** -0.5),
        "shift_mu": uniform((L, N_SHIFT), 0.0, 1.0),
        "decay_w0": uniform((L, W), -6.0, 1.0),
        "decay_w2": normal((L, DECAY_LORA, W), 0.5 * DECAY_LORA ** -0.5),
        "iclr_a0": normal((L, W), 0.5),
        "iclr_a2": normal((L, ICLR_LORA, W), ICLR_LORA ** -0.5),
        "gate_g2": normal((L, GATE_LORA, W), GATE_LORA ** -0.5),
        "k_k": uniform((L, W), 0.7, 1.0),
        "k_a": uniform((L, W), 0.8, 1.2),
        "r_k": normal((L, RWKV_HEADS, RWKV_HEAD_DIM), 0.1),
        "lnx_w": gain((L, W)),
        "lnx_b": normal((L, W), 0.02),
        "vres_w1": normal((L - 1, D, VRES_LORA), D ** -0.5),
        "vres_mu": uniform((L - 1, VRES_LORA), 0.0, 1.0),
        "vres_v0": normal((L - 1, W), 0.5),
        "vres_w2": normal((L - 1, VRES_LORA, W), VRES_LORA ** -0.5),
        "sgu_ln_g": gain((L, SGU_WIDTH)),
        "sgu_ln_b": normal((L, SGU_WIDTH), 0.02),
        "sgu_w_s": normal((L, SGU_GROUPS, SGU_CHUNK, SGU_CHUNK), 0.5 * SGU_CHUNK ** -0.5),
        "sgu_b": 1.0 + normal((L, SGU_GROUPS, SGU_CHUNK), 0.1),
        "w_b_rwkv": normal((L, W, D), W ** -0.5),
        "w_b_attn": normal((L, ATTN_OUT_WIDTH, D), ATTN_OUT_WIDTH ** -0.5),
        "w_b_sgu": normal((L, SGU_WIDTH, D), SGU_WIDTH ** -0.5),
        "w_out": normal((L, D, D), D ** -0.5),
        "mix_post_g": gain((L, D)),
        "ffn2_pre_g": gain((L, D)),
        "ffn2_w_gu": normal((L, D, 2 * F), D ** -0.5),
        "ffn2_w_down": normal((L, F, D), F ** -0.5),
        "ffn2_post_g": gain((L, D)),
    }


def reference(x, ffn1_pre_g, ffn1_w_gu, ffn1_w_down, ffn1_post_g, mix_pre_g, w_in, shift_mu,
              decay_w0, decay_w2, iclr_a0, iclr_a2, gate_g2, k_k, k_a, r_k, lnx_w, lnx_b,
              vres_w1, vres_mu, vres_v0, vres_w2, sgu_ln_g, sgu_ln_b, sgu_w_s, sgu_b,
              w_b_rwkv, w_b_attn, w_b_sgu, w_out, mix_post_g,
              ffn2_pre_g, ffn2_w_gu, ffn2_w_down, ffn2_post_g):
    B, T, D = x.shape
    W = RWKV_WIDTH
    slopes = jnp.asarray(alibi_slopes(ATTN_HEADS))
    shift_split = [W, 2 * W, 3 * W, 3 * W + DECAY_LORA, 3 * W + DECAY_LORA + ICLR_LORA]
    in_split = [N_SHIFT, N_SHIFT + N_QKV, N_SHIFT + N_QKV + N_SGU]
    h = x
    v_first = None
    for l in range(DEPTH):
        h = h + 0.5 * rms_norm(swiglu_ffn(rms_norm(h, ffn1_pre_g[l]), ffn1_w_gu[l], ffn1_w_down[l]),
                               ffn1_post_g[l])

        xn = rms_norm(h, mix_pre_g[l])
        proj = xn @ w_in[l]
        p_shift, p_qkv, p_sgu, p_gate = jnp.split(proj, in_split, axis=-1)

        p_shift = p_shift + (token_shift(p_shift) - p_shift) * shift_mu[l]
        xr, xk, xv, xw, xa, xg = jnp.split(p_shift, shift_split, axis=-1)
        if l == 0:
            v = xv
            v_first = xv
        else:
            pv = xn @ vres_w1[l - 1]
            pv = pv + (token_shift(pv) - pv) * vres_mu[l - 1]
            v = xv + (v_first - xv) * jax.nn.sigmoid(vres_v0[l - 1] + pv @ vres_w2[l - 1])
        y_rwkv = rwkv7_time_mix(xr, xk, v, xw, xa, xg, decay_w0[l], decay_w2[l], iclr_a0[l],
                                iclr_a2[l], gate_g2[l], k_k[l], k_a[l], r_k[l], lnx_w[l], lnx_b[l])

        q, k, va = (z.reshape(B, T, ATTN_HEADS, ATTN_HEAD_DIM) for z in jnp.split(p_qkv, 3, axis=-1))
        outs, lses = [], []
        for gi, (window, dilation) in enumerate(ATTN_GROUPS):
            hs = slice(gi * ATTN_HEADS_PER_GROUP, (gi + 1) * ATTN_HEADS_PER_GROUP)
            o_g, lse_g = dilated_attention_group(q[:, :, hs], k[:, :, hs], va[:, :, hs],
                                                 window, dilation, slopes[hs])
            outs.append(o_g)
            lses.append(lse_g)
        wts = jax.nn.softmax(jnp.stack(lses, axis=0), axis=0)
        y_attn = jnp.sum(wts[..., None] * jnp.stack(outs, axis=0).astype(jnp.float32), axis=0)
        y_attn = y_attn.reshape(B, T, ATTN_OUT_WIDTH).astype(x.dtype)

        u_s, v_s = jnp.split(jax.nn.gelu(p_sgu), 2, axis=-1)
        y_sgu = spatial_gating(u_s, v_s, sgu_ln_g[l], sgu_ln_b[l], sgu_w_s[l], sgu_b[l])

        gates = jax.nn.sigmoid(p_gate).reshape(B, T, N_BRANCHES, D)
        merged = (gates[:, :, 0] * (y_rwkv @ w_b_rwkv[l])
                  + gates[:, :, 1] * (y_attn @ w_b_attn[l])
                  + gates[:, :, 2] * (y_sgu @ w_b_sgu[l]))
        h = h + rms_norm(merged @ w_out[l], mix_post_g[l])

        h = h + 0.5 * rms_norm(swiglu_ffn(rms_norm(h, ffn2_pre_g[l]), ffn2_w_gu[l], ffn2_w_down[l]),
                               ffn2_post_g[l])
    return h
```

```cpp
#define GEMM_ALIGN true
#define GEMM_SP2 true
#include <hip/hip_runtime.h>
#include <hip/hip_cooperative_groups.h>
#include <cstdio>
#include <cstdint>
namespace cg = cooperative_groups;
namespace pg8 {
#define PG8_LAS __attribute__((address_space(3)))
typedef unsigned short bf16_t;
typedef short bf16x8 __attribute__((ext_vector_type(8)));
typedef float f32x4 __attribute__((ext_vector_type(4)));
typedef unsigned u32x4 __attribute__((ext_vector_type(4)));
constexpr int BM = 256, BK = 64, HALF = 128, HTB = HALF * BK * 2  , STAGE_BYTES = 8 * HTB, NXCD = 8, WGM = 8;

__host__ __device__ __forceinline__ int lds_byte(int r, int c) { const int st = (r >> 4) * 2 + (c >> 5), rr = r & 15, cc = c & 31, ob = rr * 64 + cc * 2; return st * 1024 + (ob ^ (((ob >> 9) & 1) << 5)); }
__host__ __device__ __forceinline__ void stage_rc(int b, int& R, int& C) { const int st = b / 1024, sb = b % 1024, swz = sb ^ (((sb >> 9) & 1) << 5); R = (st >> 1) * 16 + swz / 64; C = (st & 1) * 32 + (swz % 64) / 2; }
__host__ __device__ __forceinline__ int perm32(int rho) { const int n = rho >> 4, i = rho & 15; return 8 * (i >> 2) + 4 * n + (i & 3); }

struct Unit { int pm, pn; };
struct Gemm { const bf16_t* A; const bf16_t* Bt; int M, N, K; };

struct StaticOrder {
    int nM, nN, nwg, G, c;
    __host__ __device__ void init(int M, int N, int G_, int c_) { nM = M / BM; nN = N / BM; nwg = nM * nN; G = G_; c = c_; }
    __host__ __device__ bool next(int i, Unit& u) const {
        const long L = (long)i * G + c; if (L >= nwg) return false;
        int wgid = (int)L; { const int q = nwg / NXCD, r = nwg % NXCD, xcd = wgid % NXCD, off = wgid / NXCD; wgid = (xcd < r ? xcd * (q + 1) : r * (q + 1) + (xcd - r) * q) + off; }
        const int nig = WGM * nN, gid = wgid / nig, fm = gid * WGM, gsz = (nM - fm) < WGM ? (nM - fm) : WGM;
        u.pm = fm + ((wgid % nig) % gsz); u.pn = (wgid % nig) / gsz; return true;
    }
    __device__ __forceinline__ void a_ready(const Unit&) const {}
    __device__ __forceinline__ void done(const Unit&) const {}
};
__device__ __forceinline__ unsigned cvt_pk_bf16(float lo, float hi) { unsigned r; asm volatile("v_cvt_pk_bf16_f32 %0, %1, %2" : "=v"(r) : "v"(lo), "v"(hi)); return r; }
typedef float f32x2 __attribute__((ext_vector_type(2)));
template <class Epi, class Sched, bool ALIGN_EPI = false, bool SP2 = false>
__device__ __forceinline__ void gemm_phase(PG8_LAS unsigned char* lds, const Gemm g, const Sched& S, const Epi& E, int tid_in) {
    int tid_ = tid_in; asm volatile("" : "+v"(tid_));
    const int tid = tid_, wid = __builtin_amdgcn_readfirstlane(tid >> 6), lane = tid & 63, wr = wid >> 2, wc = wid & 3, fr = lane & 15, fq = lane >> 4;
    const int K = g.K, nt = K / BK;
    unsigned voffA[2], voffB[2];
#pragma unroll
    for (int i = 0; i < 2; ++i) { int R, C; stage_rc(tid * 16 + i * 8192, R, C); const int Rb = Epi::PERM ? ((R & ~31) + perm32(R & 31)) : R;
        voffA[i] = (unsigned)(R * K + C) * 2u; voffB[i] = (unsigned)(Rb * K + C) * 2u; }
    const size_t kstep = (size_t)(BK * 2);
    const size_t hstep = (size_t)HALF * K * 2;
    const size_t tstep = 2 * hstep;
    const unsigned ldsw = (unsigned)wid * 1024u;
    const int aoff = lds_byte(wr * 64 + fr, fq * 8), boff = lds_byte(wc * 32 + fr, fq * 8);
#define PG8_SA(b, h) (((b) * 2 + (h)) * HTB)
#define PG8_SB(b, h) ((4 + (b) * 2 + (h)) * HTB)
#define PG8_STAGE(bufoff, gbase, voff) do { _Pragma("unroll") for (int _i = 0; _i < 2; ++_i) \
        __builtin_amdgcn_global_load_lds((const unsigned*)((const char*)(gbase) + (voff)[_i]), (PG8_LAS unsigned*)(lds + (bufoff) + ldsw + _i * 8192), 16, 0, 0); } while (0)
#define PG8_LDA(dst, b, h) do { _Pragma("unroll") for (int m = 0; m < 4; ++m) _Pragma("unroll") for (int k = 0; k < 2; ++k) dst[m][k] = *(const PG8_LAS bf16x8*)(lds + PG8_SA(b, h) + aoff + m * 2048 + k * 1024); } while (0)
#define PG8_LDB(dst, b, h) do { _Pragma("unroll") for (int n = 0; n < 2; ++n) _Pragma("unroll") for (int k = 0; k < 2; ++k) dst[n][k] = *(const PG8_LAS bf16x8*)(lds + PG8_SB(b, h) + boff + n * 2048 + k * 1024); } while (0)
#define PG8_MMA(ai, bj, At, Bt) do { __builtin_amdgcn_s_setprio(1); _Pragma("unroll") for (int m = 0; m < 4; ++m) _Pragma("unroll") for (int n = 0; n < 2; ++n) _Pragma("unroll") for (int k = 0; k < 2; ++k) \
        acc[ai][bj][m][n] = __builtin_amdgcn_mfma_f32_16x16x32_bf16(Bt[n][k], At[m][k], acc[ai][bj][m][n], 0, 0, 0); __builtin_amdgcn_s_setprio(0); } while (0)
#ifdef DRAIN_ALL
#define PG8_WAIT_V(n) asm volatile("s_waitcnt vmcnt(0)" ::: "memory")
#else
#define PG8_WAIT_V(n) asm volatile("s_waitcnt vmcnt(" #n ")" ::: "memory")
#endif
#define PG8_WAIT_L(n) asm volatile("s_waitcnt lgkmcnt(" #n ")" ::: "memory")
#define PG8_BAR __builtin_amdgcn_s_barrier()
#define PG8_SCHED __builtin_amdgcn_sched_barrier(0)
    Unit cur, nxt; int ui = 0;
    if (!S.next(0, cur)) return;
    f32x4 acc[2][2][4][2];
#pragma unroll
    for (int a = 0; a < 2; ++a)
#pragma unroll
        for (int b = 0; b < 2; ++b)
#pragma unroll
            for (int m = 0; m < 4; ++m)
#pragma unroll
                for (int n = 0; n < 2; ++n) acc[a][b][m][n] = (f32x4){0.f, 0.f, 0.f, 0.f};
    bf16x8 At[4][2], B0[2][2], B1[2][2];
    const char* cA = (const char*)g.A + (size_t)cur.pm * tstep; const char* cB = (const char*)g.Bt + (size_t)cur.pn * tstep;
    S.a_ready(cur);
    if constexpr (SP2) {
        PG8_STAGE(PG8_SB(0, 0), cB, voffB); PG8_STAGE(PG8_SB(0, 1), cB + hstep, voffB); PG8_STAGE(PG8_SA(0, 0), cA, voffA); PG8_STAGE(PG8_SA(0, 1), cA + hstep, voffA);
        if (wr == 1) PG8_BAR;
        PG8_WAIT_V(2); PG8_BAR;
        PG8_STAGE(PG8_SB(1, 0), cB + kstep, voffB); PG8_STAGE(PG8_SA(1, 0), cA + kstep, voffA); PG8_STAGE(PG8_SB(1, 1), cB + hstep + kstep, voffB);
        PG8_WAIT_V(6); PG8_BAR;
    } else {
        PG8_STAGE(PG8_SB(0, 0), cB, voffB); PG8_STAGE(PG8_SA(0, 0), cA, voffA); PG8_STAGE(PG8_SB(0, 1), cB + hstep, voffB); PG8_STAGE(PG8_SA(0, 1), cA + hstep, voffA);
        if (wr == 1) PG8_BAR;
        PG8_WAIT_V(4); PG8_BAR;
        PG8_STAGE(PG8_SB(1, 0), cB + kstep, voffB); PG8_STAGE(PG8_SA(1, 0), cA + kstep, voffA); PG8_STAGE(PG8_SB(1, 1), cB + hstep + kstep, voffB);
        PG8_WAIT_V(6); PG8_BAR;
    }
    for (;;) {
        const bool has_next = S.next(ui + 1, nxt);
        const char* nA = has_next ? (const char*)g.A + (size_t)nxt.pm * tstep : cA; const char* nB = has_next ? (const char*)g.Bt + (size_t)nxt.pn * tstep : cB;
        for (int t = 0; t < nt; t += 2) {
            const bool last = (t == nt - 2);
            const char* a1 = cA + (size_t)(t + 1) * kstep;
            const char* a2 = last ? nA : cA + (size_t)(t + 2) * kstep; const char* b2 = last ? nB : cB + (size_t)(t + 2) * kstep;
            const char* a3 = a2 + kstep; const char* b3 = b2 + kstep;
            if (last && has_next) S.a_ready(nxt);
            if constexpr (SP2) {
            PG8_LDB(B0, 0, 0); PG8_LDB(B1, 0, 1); PG8_SCHED; PG8_LDA(At, 0, 0); PG8_STAGE(PG8_SA(1, 1), a1 + hstep, voffA);
            PG8_WAIT_V(8); PG8_WAIT_L(0); PG8_BAR; PG8_MMA(0, 0, At, B0); PG8_MMA(0, 1, At, B1); PG8_BAR; PG8_SCHED;
            PG8_LDA(At, 0, 1); PG8_STAGE(PG8_SB(0, 0), b2, voffB); PG8_STAGE(PG8_SB(0, 1), b2 + hstep, voffB); PG8_STAGE(PG8_SA(0, 0), a2, voffA);
            PG8_WAIT_V(8); PG8_WAIT_L(0); PG8_BAR; PG8_MMA(1, 0, At, B0); PG8_MMA(1, 1, At, B1); PG8_BAR; PG8_SCHED;
            PG8_LDB(B0, 1, 0); PG8_LDB(B1, 1, 1); PG8_SCHED; PG8_LDA(At, 1, 0); PG8_STAGE(PG8_SA(0, 1), a2 + hstep, voffA);
            PG8_WAIT_V(8); PG8_WAIT_L(0); PG8_BAR; PG8_MMA(0, 0, At, B0); PG8_MMA(0, 1, At, B1); PG8_BAR; PG8_SCHED;
            PG8_LDA(At, 1, 1); PG8_STAGE(PG8_SB(1, 0), b3, voffB); PG8_STAGE(PG8_SB(1, 1), b3 + hstep, voffB); PG8_STAGE(PG8_SA(1, 0), a3, voffA);
            PG8_WAIT_V(8); PG8_WAIT_L(0); PG8_BAR; PG8_MMA(1, 0, At, B0); PG8_MMA(1, 1, At, B1); PG8_BAR; PG8_SCHED;
            } else {
            PG8_LDB(B0, 0, 0); PG8_SCHED; PG8_LDA(At, 0, 0); PG8_STAGE(PG8_SA(1, 1), a1 + hstep, voffA);
            PG8_WAIT_L(8); PG8_BAR; PG8_WAIT_L(0); PG8_MMA(0, 0, At, B0); PG8_BAR; PG8_SCHED;
            PG8_LDB(B1, 0, 1); PG8_STAGE(PG8_SB(0, 0), b2, voffB);
            PG8_BAR; PG8_WAIT_L(0); PG8_MMA(0, 1, At, B1); PG8_BAR;
            PG8_LDA(At, 0, 1); PG8_STAGE(PG8_SA(0, 0), a2, voffA);
            PG8_BAR; PG8_WAIT_L(0); PG8_MMA(1, 0, At, B0); PG8_BAR; PG8_SCHED;
            PG8_STAGE(PG8_SB(0, 1), b2 + hstep, voffB);
            PG8_WAIT_V(6); PG8_BAR; PG8_MMA(1, 1, At, B1); PG8_BAR;
            PG8_LDB(B0, 1, 0); PG8_SCHED; PG8_LDA(At, 1, 0); PG8_STAGE(PG8_SA(0, 1), a2 + hstep, voffA);
            PG8_WAIT_L(8); PG8_BAR; PG8_WAIT_L(0); PG8_MMA(0, 0, At, B0); PG8_BAR; PG8_SCHED;
            PG8_LDB(B1, 1, 1); PG8_STAGE(PG8_SB(1, 0), b3, voffB);
            PG8_BAR; PG8_WAIT_L(0); PG8_MMA(0, 1, At, B1); PG8_BAR;
            PG8_LDA(At, 1, 1); PG8_STAGE(PG8_SA(1, 0), a3, voffA);
            PG8_BAR; PG8_WAIT_L(0); PG8_MMA(1, 0, At, B0); PG8_BAR; PG8_SCHED;
            PG8_STAGE(PG8_SB(1, 1), b3 + hstep, voffB);
            PG8_WAIT_V(6); PG8_BAR; PG8_MMA(1, 1, At, B1); PG8_BAR;
            }
        }
        if constexpr (ALIGN_EPI) { if (wr == 0) PG8_BAR; }
        if constexpr (!Epi::AFTER_DRAIN) { E(acc, cur, wr, wc, fr, fq); S.done(cur); }
        if (!has_next) break;
#pragma unroll
        for (int a = 0; a < 2; ++a)
#pragma unroll
            for (int b = 0; b < 2; ++b)
#pragma unroll
                for (int m = 0; m < 4; ++m)
#pragma unroll
                    for (int n = 0; n < 2; ++n) acc[a][b][m][n] = (f32x4){0.f, 0.f, 0.f, 0.f};
        cur = nxt; cA = nA; cB = nB; ++ui;
        if constexpr (ALIGN_EPI) { if (wr == 1) PG8_BAR; }
    }
    PG8_WAIT_V(0);
    if constexpr (!ALIGN_EPI) { if (wr == 0) PG8_BAR; }
    PG8_BAR;
    if constexpr (Epi::AFTER_DRAIN) { E.fused(acc, cur, wr, wc, fr, fq, lds, wid, lane); S.done(cur); }
#undef PG8_SA
#undef PG8_SB
#undef PG8_STAGE
#undef PG8_LDA
#undef PG8_LDB
#undef PG8_MMA
#undef PG8_WAIT_V
#undef PG8_WAIT_L
#undef PG8_BAR
#undef PG8_SCHED
}
}
#define LAS __attribute__((address_space(3)))
typedef unsigned short bf16;
typedef pg8::f32x4 f32x4;
typedef pg8::bf16x8 bf16x8;
typedef pg8::u32x4 u32x4;
typedef unsigned u32x2 __attribute__((ext_vector_type(2)));
using pg8::cvt_pk_bf16;

constexpr int TT = 4096, MROWS = 8192, DM = 2048, FF = 5504, RW = 1024;
constexpr int NPROJ = 15360, PC_PV = 3360, PC_QKV = 3584, PC_SGU = 8192, PC_GATE = 9216;
constexpr int KLORA = 384;
constexpr size_t MiB = 1u << 20;
constexpr size_t WS_WGU1 = 1 * MiB, WS_WD1 = 44 * MiB, WS_WIN = 65 * MiB + MiB / 2, WS_WBR_R = 125 * MiB + MiB / 2, WS_WBR_A = 129 * MiB + MiB / 2,
                 WS_WBR_S = 131 * MiB + MiB / 2, WS_WOUT = 133 * MiB + MiB / 2, WS_WGU2 = 141 * MiB + MiB / 2, WS_WD2 = 184 * MiB + MiB / 2, WS_WLORA = 206 * MiB,
                 WS_XN = 209 * MiB, WS_VFIRST = 241 * MiB, WS_U = 273 * MiB;
constexpr size_t WS_PROJ = WS_U, WS_ACT = WS_U, WS_YF = WS_U + 96 * MiB;
constexpr size_t WS_R = 513 * MiB, WS_K = 545 * MiB, WS_KK = 577 * MiB, WS_BV = 609 * MiB, WS_WDEC = 641 * MiB, WS_ASIG = 673 * MiB, WS_VG = 705 * MiB, WS_G = 737 * MiB,
                 WS_ALORA = 753 * MiB, WS_OATT = 759 * MiB, WS_LSE = 807 * MiB, WS_YSGU = 808 * MiB, WS_YATT = 816 * MiB, WS_END = 824 * MiB;
constexpr size_t WS_MERGED_F32 = WS_R, WS_MERGED_BF = WS_KK, WS_Y = WS_BV, WS_YS = WS_ASIG, WS_YRWKV = WS_VG;
constexpr int LDS_BYTES = 147456;

enum { I_X = 0, I_F1PRE, I_F1GU, I_F1DN, I_F1POST, I_MIXPRE, I_WIN, I_SHMU, I_DW0, I_DW2, I_A0, I_A2, I_G2, I_KK, I_KA, I_RK, I_LNXW, I_LNXB,
       I_VW1, I_VMU, I_VV0, I_VW2, I_SLNG, I_SLNB, I_SWS, I_SB, I_WBR, I_WBA, I_WBS, I_WOUT, I_MIXPOST, I_F2PRE, I_F2GU, I_F2DN, I_F2POST, N_INPUTS };
struct Args { const float* in[N_INPUTS]; float* out; unsigned char* ws; int ph_lo, ph_hi; };
typedef const __attribute__((address_space(4))) Args CArgs;
__device__ __forceinline__ CArgs* get_args() { CArgs* p = (CArgs*)__builtin_amdgcn_kernarg_segment_ptr(); asm volatile("" : "+s"(p)); return p; }

__device__ __forceinline__ float bf2f(unsigned v) { return __uint_as_float(v << 16); }
__device__ __forceinline__ float bflo(unsigned w) { return __uint_as_float(w << 16); }
__device__ __forceinline__ float bfhi(unsigned w) { return __uint_as_float(w & 0xffff0000u); }
__device__ __forceinline__ unsigned short f2bf1(float f) { return (unsigned short)(cvt_pk_bf16(f, 0.f) & 0xffffu); }
__device__ __forceinline__ float sigmoidf_(float x) { return __builtin_amdgcn_rcpf(1.0f + __expf(-x)); }
__device__ __forceinline__ float tanhf_(float x) { return 2.0f * sigmoidf_(2.0f * x) - 1.0f; }
__device__ __forceinline__ float siluf_(float x) { return x * sigmoidf_(x); }
__device__ __forceinline__ float gelutf_(float x) { const float u = 0.7978845608028654f * (x + 0.044715f * x * x * x); return x * sigmoidf_(2.0f * u); }
template <int CTRL> __device__ __forceinline__ float dppf(float x) { return __builtin_bit_cast(float, __builtin_amdgcn_mov_dpp(__builtin_bit_cast(int, x), CTRL, 0xf, 0xf, true)); }
__device__ __forceinline__ float row16_sum(float x) { x += dppf<0xB1>(x); x += dppf<0x4E>(x); x += dppf<0x141>(x); x += dppf<0x128>(x); return x; }
__device__ __forceinline__ float row16_max(float x) { x = fmaxf(x, dppf<0xB1>(x)); x = fmaxf(x, dppf<0x4E>(x)); x = fmaxf(x, dppf<0x141>(x)); x = fmaxf(x, dppf<0x128>(x)); return x; }
__device__ __forceinline__ float wave_sum(float v) {
    v = row16_sum(v);
    const int iv = __builtin_bit_cast(int, v);
    const float s0 = __builtin_bit_cast(float, __builtin_amdgcn_readlane(iv, 0)), s1 = __builtin_bit_cast(float, __builtin_amdgcn_readlane(iv, 16)),
                s2 = __builtin_bit_cast(float, __builtin_amdgcn_readlane(iv, 32)), s3 = __builtin_bit_cast(float, __builtin_amdgcn_readlane(iv, 48));
    return (s0 + s1) + (s2 + s3);
}
#define LDS_WAIT() asm volatile("s_waitcnt lgkmcnt(0)" ::: "memory")

using pg8::Unit; using pg8::BM; using pg8::HALF;
struct EpiSwiglu {
    static constexpr bool PERM = true, AFTER_DRAIN = false;
    bf16* O;
    __device__ __forceinline__ void operator()(const f32x4 (&acc)[2][2][4][2], const Unit& u, int wr, int wc, int fr, int fq) const {
        const int row0 = u.pm * BM + wr * 64 + fr, col0 = u.pn * 128 + wc * 32 + 8 * fq;
#pragma unroll
        for (int ai = 0; ai < 2; ++ai)
#pragma unroll
            for (int m = 0; m < 4; ++m) {
                bf16* rowp = O + (size_t)(row0 + ai * HALF + m * 16) * FF + col0;
                const f32x4 g0 = acc[ai][0][m][0], g1 = acc[ai][0][m][1], u0 = acc[ai][1][m][0], u1 = acc[ai][1][m][1];
                u32x4 w;
                w.x = cvt_pk_bf16(siluf_(g0[0]) * u0[0], siluf_(g0[1]) * u0[1]); w.y = cvt_pk_bf16(siluf_(g0[2]) * u0[2], siluf_(g0[3]) * u0[3]);
                w.z = cvt_pk_bf16(siluf_(g1[0]) * u1[0], siluf_(g1[1]) * u1[1]); w.w = cvt_pk_bf16(siluf_(g1[2]) * u1[2], siluf_(g1[3]) * u1[3]);
                *(u32x4*)rowp = w;
            }
    }
};
struct EpiF32 {
    static constexpr bool PERM = false, AFTER_DRAIN = false;
    float* C; int ldc;
    __device__ __forceinline__ void operator()(const f32x4 (&acc)[2][2][4][2], const Unit& u, int wr, int wc, int fr, int fq) const {
        const int row0 = u.pm * BM + wr * 64 + fr, col0 = u.pn * BM + wc * 32 + 4 * fq;
#pragma unroll
        for (int ai = 0; ai < 2; ++ai)
#pragma unroll
            for (int m = 0; m < 4; ++m) { float* rowp = C + (size_t)(row0 + ai * HALF + m * 16) * ldc + col0;
#pragma unroll
                for (int bj = 0; bj < 2; ++bj)
#pragma unroll
                    for (int n = 0; n < 2; ++n) *(f32x4*)(rowp + bj * HALF + n * 16) = acc[ai][bj][m][n]; }
    }
};
struct EpiProj {
    static constexpr bool PERM = true, AFTER_DRAIN = false;
    bf16* O;
    __device__ __forceinline__ void operator()(const f32x4 (&acc)[2][2][4][2], const Unit& u, int wr, int wc, int fr, int fq) const {
        const int row0 = u.pm * BM + wr * 64 + fr, col0 = u.pn * BM + wc * 32 + 8 * fq;
        const int mode = u.pn < 32 ? 0 : (u.pn < 36 ? 1 : 2);
#pragma unroll
        for (int ai = 0; ai < 2; ++ai)
#pragma unroll
            for (int m = 0; m < 4; ++m) { bf16* rowp = O + (size_t)(row0 + ai * HALF + m * 16) * NPROJ + col0;
#pragma unroll
                for (int bj = 0; bj < 2; ++bj) { f32x4 v0 = acc[ai][bj][m][0], v1 = acc[ai][bj][m][1];
                    if (mode == 1) {
#pragma unroll
                        for (int j = 0; j < 4; ++j) { v0[j] = gelutf_(v0[j]); v1[j] = gelutf_(v1[j]); } }
                    else if (mode == 2) {
#pragma unroll
                        for (int j = 0; j < 4; ++j) { v0[j] = sigmoidf_(v0[j]); v1[j] = sigmoidf_(v1[j]); } }
                    u32x4 w; w.x = cvt_pk_bf16(v0[0], v0[1]); w.y = cvt_pk_bf16(v0[2], v0[3]); w.z = cvt_pk_bf16(v1[0], v1[1]); w.w = cvt_pk_bf16(v1[2], v1[3]);
                    *(u32x4*)(rowp + bj * HALF) = w; } }
    }
};
template <int MODE> __device__ __forceinline__ void lora_store(const f32x4 (&acc)[2][2][4][2], int row0, int col0, const float* bias, float* dstf, bf16* dstb) {
#pragma unroll
    for (int ai = 0; ai < 2; ++ai)
#pragma unroll
        for (int m = 0; m < 4; ++m) { const size_t roff = (size_t)(row0 + ai * HALF + m * 16) * RW;
#pragma unroll
            for (int bj = 0; bj < 2; ++bj)
#pragma unroll
                for (int n = 0; n < 2; ++n) { const int col = col0 + bj * HALF + n * 16; f32x4 v = acc[ai][bj][m][n];
                    if (MODE == 2) { u32x2 w; w.x = cvt_pk_bf16(v[0], v[1]); w.y = cvt_pk_bf16(v[2], v[3]); *(u32x2*)(dstb + roff + col) = w; }
                    else { v = v + *(const f32x4*)(bias + col);
                        if (MODE == 0) {
#pragma unroll
                            for (int j = 0; j < 4; ++j) { const float z = -v[j]; const float sp = fmaxf(z, 0.f) + __logf(1.0f + __expf(-fabsf(z))); v[j] = __expf(-__expf(-sp - 0.5f)); } }
                        else {
#pragma unroll
                            for (int j = 0; j < 4; ++j) v[j] = sigmoidf_(v[j]); }
                        *(f32x4*)(dstf + roff + col) = v; } }
            asm volatile("" ::: "memory"); }
}
struct EpiLora {
    static constexpr bool PERM = false, AFTER_DRAIN = false;
    int l;
    __device__ __forceinline__ void operator()(const f32x4 (&acc)[2][2][4][2], const Unit& u, int wr, int wc, int fr, int fq) const {
        CArgs* ap = get_args(); unsigned char* ws = ap->ws;
        const int row0 = u.pm * BM + wr * 64 + fr; const int blk = u.pn >> 2; const int col0 = (u.pn & 3) * BM + wc * 32 + 4 * fq;
        if (blk == 0) lora_store<0>(acc, row0, col0, ap->in[I_DW0] + (size_t)l * RW, (float*)(ws + WS_WDEC), nullptr);
        else if (blk == 1) lora_store<1>(acc, row0, col0, ap->in[I_A0] + (size_t)l * RW, (float*)(ws + WS_ASIG), nullptr);
        else if (blk == 2) lora_store<2>(acc, row0, col0, nullptr, nullptr, (bf16*)(ws + WS_G));
        else lora_store<1>(acc, row0, col0, ap->in[I_VV0], (float*)(ws + WS_VG), nullptr);
    }
};
template <int PASS> struct EpiMerge {
    static constexpr bool PERM = false, AFTER_DRAIN = false;
    float* Mf; bf16* Mb; const bf16* gate;
    __device__ __forceinline__ void operator()(const f32x4 (&acc)[2][2][4][2], const Unit& u, int wr, int wc, int fr, int fq) const {
        const int row0 = u.pm * BM + wr * 64 + fr, col0 = u.pn * BM + wc * 32 + 4 * fq;
#pragma unroll
        for (int ai = 0; ai < 2; ++ai)
#pragma unroll
            for (int m = 0; m < 4; ++m) { const int row = row0 + ai * HALF + m * 16;
#pragma unroll
                for (int bj = 0; bj < 2; ++bj)
#pragma unroll
                    for (int n = 0; n < 2; ++n) { const int col = col0 + bj * HALF + n * 16; const size_t off = (size_t)row * DM + col;
                        const u32x2 gw = *(const u32x2*)(gate + (size_t)row * NPROJ + col);
                        f32x4 g; g[0] = bflo(gw.x); g[1] = bfhi(gw.x); g[2] = bflo(gw.y); g[3] = bfhi(gw.y);
                        f32x4 v = acc[ai][bj][m][n] * g;
                        if (PASS > 0) v = v + *(const f32x4*)(Mf + off);
                        if (PASS < 2) *(f32x4*)(Mf + off) = v;
                        else { u32x2 w; w.x = cvt_pk_bf16(v[0], v[1]); w.y = cvt_pk_bf16(v[2], v[3]); *(u32x2*)(Mb + off) = w; } } }
    }
};
struct Ctx { LAS unsigned char* lds; int tid, lane, wave, G, bx, gw, NGW; };

__device__ __forceinline__ void tr_item(const float* src, int ldn, int sc0, int k0, bf16* dst, int Kd, int dr0, LAS float* scr, int lane, bool zero) {
    const int c = lane & 7;
    if (zero) {
#pragma unroll
        for (int j = 0; j < 4; ++j) { const int n = (lane >> 3) + 8 * j; *(u32x4*)(dst + (size_t)(dr0 + n) * Kd + k0 + 8 * c) = (u32x4){0u, 0u, 0u, 0u}; }
        return;
    }
#pragma unroll 8
    for (int i = 0; i < 32; ++i) { const int kk = 2 * i + (lane >> 5); scr[kk * 33 + (lane & 31)] = src[(size_t)(k0 + kk) * ldn + sc0 + (lane & 31)]; }
    LDS_WAIT(); asm volatile("" ::: "memory");
#pragma unroll
    for (int j = 0; j < 4; ++j) { const int n = (lane >> 3) + 8 * j; const LAS float* s = scr + (8 * c) * 33 + n;
        u32x4 o; o.x = cvt_pk_bf16(s[0 * 33], s[1 * 33]); o.y = cvt_pk_bf16(s[2 * 33], s[3 * 33]); o.z = cvt_pk_bf16(s[4 * 33], s[5 * 33]); o.w = cvt_pk_bf16(s[6 * 33], s[7 * 33]);
        *(u32x4*)(dst + (size_t)(dr0 + n) * Kd + k0 + 8 * c) = o; }
    LDS_WAIT(); asm volatile("" ::: "memory");
}
__device__ __forceinline__ void convert_phase(const Ctx& C, int l) {
    CArgs* ap = get_args();
    unsigned char* ws = ap->ws;
    LAS float* scr = (LAS float*)(C.lds + C.wave * 8704);
    constexpr int N_GU = (2 * FF / 32) * (DM / 64), N_DN = (DM / 32) * (FF / 64), N_IN = (NPROJ / 32) * (DM / 64), N_BR = (DM / 32) * (RW / 64), N_BA = (DM / 32) * (512 / 64), N_WO = (DM / 32) * (DM / 64);
    constexpr int TOTAL = 2 * N_GU + 2 * N_DN + N_IN + N_BR + 2 * N_BA + N_WO;
    for (int it = C.gw; it < TOTAL; it += C.NGW) {
        int r = it;
        if (r < 2 * N_GU) {
            const int which = r >= N_GU; if (which) r -= N_GU;
            const float* src = ap->in[which ? I_F2GU : I_F1GU] + (size_t)l * DM * 2 * FF; bf16* dst = (bf16*)(ws + (which ? WS_WGU2 : WS_WGU1));
            const int nblk = 2 * FF / 32, nb = r % nblk, kb = r / nblk, rho0 = 32 * nb; const int pn = rho0 >> 8, bj = (rho0 >> 7) & 1, i0 = rho0 & 127;
            tr_item(src, 2 * FF, bj * FF + 128 * pn + i0, 64 * kb, dst, DM, rho0, scr, C.lane, false); continue; }
        r -= 2 * N_GU;
        if (r < 2 * N_DN) {
            const int which = r >= N_DN; if (which) r -= N_DN;
            const float* src = ap->in[which ? I_F2DN : I_F1DN] + (size_t)l * FF * DM; bf16* dst = (bf16*)(ws + (which ? WS_WD2 : WS_WD1));
            const int nblk = DM / 32, nb = r % nblk, kb = r / nblk;
            tr_item(src, DM, 32 * nb, 64 * kb, dst, FF, 32 * nb, scr, C.lane, false); continue; }
        r -= 2 * N_DN;
        if (r < N_IN) {
            const int nblk = NPROJ / 32, nb = r % nblk, kb = r / nblk, rho0 = 32 * nb; bf16* dst = (bf16*)(ws + WS_WIN);
            if (rho0 < PC_PV) tr_item(ap->in[I_WIN] + (size_t)l * DM * 15136, 15136, rho0, 64 * kb, dst, DM, rho0, scr, C.lane, false);
            else if (rho0 == PC_PV) tr_item(ap->in[I_VW1], 32, 0, 64 * kb, dst, DM, rho0, scr, C.lane, l == 0);
            else if (rho0 < PC_QKV) tr_item(ap->in[I_WIN], 15136, 0, 64 * kb, dst, DM, rho0, scr, C.lane, true);
            else tr_item(ap->in[I_WIN] + (size_t)l * DM * 15136, 15136, rho0 - 224, 64 * kb, dst, DM, rho0, scr, C.lane, false);
            continue; }
        r -= N_IN;
        if (r < N_BR) { const int nblk = DM / 32, nb = r % nblk, kb = r / nblk;
            tr_item(ap->in[I_WBR] + (size_t)l * RW * DM, DM, 32 * nb, 64 * kb, (bf16*)(ws + WS_WBR_R), RW, 32 * nb, scr, C.lane, false); continue; }
        r -= N_BR;
        if (r < 2 * N_BA) { const int which = r >= N_BA; if (which) r -= N_BA; const int nblk = DM / 32, nb = r % nblk, kb = r / nblk;
            tr_item(ap->in[which ? I_WBS : I_WBA] + (size_t)l * 512 * DM, DM, 32 * nb, 64 * kb, (bf16*)(ws + (which ? WS_WBR_S : WS_WBR_A)), 512, 32 * nb, scr, C.lane, false); continue; }
        r -= 2 * N_BA;
        { const int nblk = DM / 32, nb = r % nblk, kb = r / nblk;
            tr_item(ap->in[I_WOUT] + (size_t)l * DM * DM, DM, 32 * nb, 64 * kb, (bf16*)(ws + WS_WOUT), DM, 32 * nb, scr, C.lane, false); }
    }
    bf16* wl = (bf16*)(ws + WS_WLORA);
    for (int idx = C.bx * 512 + C.tid; idx < 4096 * KLORA; idx += C.G * 512) {
        const int n = idx & 1023, rest = idx >> 10, k = rest % KLORA, blk = rest / KLORA;
        float v = 0.f;
        if (blk == 0) { if (k < 64) v = ap->in[I_DW2][(size_t)l * 64 * RW + (size_t)k * RW + n]; }
        else if (blk == 1) { if (k >= 64 && k < 128) v = ap->in[I_A2][(size_t)l * 64 * RW + (size_t)(k - 64) * RW + n]; }
        else if (blk == 2) { if (k >= 128 && k < 288) v = ap->in[I_G2][(size_t)l * 160 * RW + (size_t)(k - 128) * RW + n]; }
        else { if (l > 0 && k >= 288 && k < 320) v = ap->in[I_VW2][(size_t)(k - 288) * RW + n]; }
        wl[(size_t)(blk * 1024 + n) * KLORA + k] = f2bf1(v);
    }
}

__device__ __forceinline__ void prenorm_phase(const Ctx& C, const float* x, const float* g, bf16* xn) {
    for (int row = C.gw; row < MROWS; row += C.NGW) {
        const f32x4* xr = (const f32x4*)(x + (size_t)row * DM) + C.lane; f32x4 v[8]; float ss = 0.f;
#pragma unroll
        for (int j = 0; j < 8; ++j) { v[j] = xr[64 * j]; ss += (v[j][0] * v[j][0] + v[j][1] * v[j][1]) + (v[j][2] * v[j][2] + v[j][3] * v[j][3]); }
        const float rs = rsqrtf(wave_sum(ss) * (1.0f / DM) + 1e-6f);
        u32x2* o = (u32x2*)(xn + (size_t)row * DM) + C.lane;
#pragma unroll
        for (int j = 0; j < 8; ++j) { const f32x4 gg = ((const f32x4*)g)[C.lane + 64 * j]; u32x2 w; w.x = cvt_pk_bf16(v[j][0] * rs * gg[0], v[j][1] * rs * gg[1]); w.y = cvt_pk_bf16(v[j][2] * rs * gg[2], v[j][3] * rs * gg[3]); o[64 * j] = w; }
    }
}
__device__ __forceinline__ void norm_phase(const Ctx& C, const float* y, const float* post_g, float fac, const float* h_in, float* h_out, const float* pre_g, bf16* xn) {
    for (int row = C.gw; row < MROWS; row += C.NGW) {
        const f32x4* yr = (const f32x4*)(y + (size_t)row * DM) + C.lane; const f32x4* hr = (const f32x4*)(h_in + (size_t)row * DM) + C.lane;
        f32x4 v[8]; float ss = 0.f;
#pragma unroll
        for (int j = 0; j < 8; ++j) { v[j] = yr[64 * j]; ss += (v[j][0] * v[j][0] + v[j][1] * v[j][1]) + (v[j][2] * v[j][2] + v[j][3] * v[j][3]); }
        const float rs = rsqrtf(wave_sum(ss) * (1.0f / DM) + 1e-6f) * fac;
        float s2 = 0.f; f32x4* ho = (f32x4*)(h_out + (size_t)row * DM) + C.lane;
#pragma unroll
        for (int j = 0; j < 8; ++j) { const f32x4 gg = ((const f32x4*)post_g)[C.lane + 64 * j]; const f32x4 hh = hr[64 * j];
            v[j] = hh + v[j] * rs * gg; s2 += (v[j][0] * v[j][0] + v[j][1] * v[j][1]) + (v[j][2] * v[j][2] + v[j][3] * v[j][3]); ho[64 * j] = v[j]; }
        if (pre_g) {
            const float r2 = rsqrtf(wave_sum(s2) * (1.0f / DM) + 1e-6f);
            u32x2* o = (u32x2*)(xn + (size_t)row * DM) + C.lane;
#pragma unroll
            for (int j = 0; j < 8; ++j) { const f32x4 gg = ((const f32x4*)pre_g)[C.lane + 64 * j]; u32x2 w; w.x = cvt_pk_bf16(v[j][0] * r2 * gg[0], v[j][1] * r2 * gg[1]); w.y = cvt_pk_bf16(v[j][2] * r2 * gg[2], v[j][3] * r2 * gg[3]); o[64 * j] = w; }
        }
    }
}

__device__ __forceinline__ f32x4 ld_bf4(const bf16* p) { const u32x2 w = *(const u32x2*)p; f32x4 r; r[0] = bflo(w.x); r[1] = bfhi(w.x); r[2] = bflo(w.y); r[3] = bfhi(w.y); return r; }
__device__ __forceinline__ void loraA_phase(const Ctx& C, int l) {
    CArgs* ap = get_args();
    const bf16* proj = (const bf16*)(ap->ws + WS_PROJ); bf16* A = (bf16*)(ap->ws + WS_ALORA);
    const float* mu = ap->in[I_SHMU] + (size_t)l * 3360;
    for (int row = C.gw; row < MROWS; row += C.NGW) {
        const bool first = (row % TT) == 0;
        const bf16* p1 = proj + (size_t)row * NPROJ + 3072; const bf16* p0 = proj + (size_t)(first ? row : row - 1) * NPROJ + 3072;
        bf16* arow = A + (size_t)row * KLORA;
#pragma unroll
        for (int h = 0; h < 2; ++h) { const int g = C.lane + 64 * h;
            if (g < 96) { const int c = 4 * g; f32x4 val = (f32x4){0.f, 0.f, 0.f, 0.f};
                if (c < 320) {
                    const f32x4 p = ld_bf4(p1 + c); f32x4 pp = ld_bf4(p0 + c); if (first) pp = (f32x4){0.f, 0.f, 0.f, 0.f};
                    f32x4 m = (f32x4){0.f, 0.f, 0.f, 0.f};
                    if (c < 288) m = *(const f32x4*)(mu + 3072 + c); else if (l > 0) m = *(const f32x4*)(ap->in[I_VMU] + (c - 288));
                    const f32x4 sv = p + (pp - p) * m;
#pragma unroll
                    for (int e = 0; e < 4; ++e) val[e] = c < 64 ? tanhf_(sv[e]) : (c < 128 ? sv[e] : (c < 288 ? sigmoidf_(sv[e]) : (l > 0 ? sv[e] : 0.f)));
                }
                u32x2 w; w.x = cvt_pk_bf16(val[0], val[1]); w.y = cvt_pk_bf16(val[2], val[3]); *(u32x2*)(arow + c) = w; } }
    }
}

__device__ __forceinline__ void prep_phase(const Ctx& C, int l) {
    CArgs* ap = get_args();
    unsigned char* ws = ap->ws; const bf16* proj = (const bf16*)(ws + WS_PROJ);
    float* R = (float*)(ws + WS_R); float* K = (float*)(ws + WS_K); float* KK = (float*)(ws + WS_KK); float* BV = (float*)(ws + WS_BV); float* V = (float*)(ws + WS_VFIRST);
    const float* AS = (const float*)(ws + WS_ASIG); const float* VG = (const float*)(ws + WS_VG);
    const float* mu = ap->in[I_SHMU] + (size_t)l * 3360; const float* kkw = ap->in[I_KK] + (size_t)l * RW; const float* kaw = ap->in[I_KA] + (size_t)l * RW;
    for (int row = C.gw; row < MROWS; row += C.NGW) {
        const bool first = (row % TT) == 0; const bf16* p1 = proj + (size_t)row * NPROJ; const bf16* p0 = proj + (size_t)(first ? row : row - 1) * NPROJ;
#pragma unroll
        for (int i = 0; i < 4; ++i) { const int col = i * 256 + C.lane * 4; const size_t off = (size_t)row * RW + col;
            f32x4 xr = ld_bf4(p1 + col), xk = ld_bf4(p1 + 1024 + col), xv = ld_bf4(p1 + 2048 + col);
            f32x4 qr = ld_bf4(p0 + col), qk = ld_bf4(p0 + 1024 + col), qv = ld_bf4(p0 + 2048 + col);
            if (first) { qr = (f32x4){0.f, 0.f, 0.f, 0.f}; qk = qr; qv = qr; }
            xr = xr + (qr - xr) * *(const f32x4*)(mu + col); xk = xk + (qk - xk) * *(const f32x4*)(mu + 1024 + col); xv = xv + (qv - xv) * *(const f32x4*)(mu + 2048 + col);
            f32x4 v = xv;
            if (l > 0) { const f32x4 vf = *(const f32x4*)(V + off), vg = *(const f32x4*)(VG + off); v = xv + (vf - xv) * vg; }
            *(f32x4*)(V + off) = v;
            const f32x4 as = *(const f32x4*)(AS + off);
            const f32x4 kr = xk * *(const f32x4*)(kkw + col);
            float ssq = (kr[0] * kr[0] + kr[1] * kr[1]) + (kr[2] * kr[2] + kr[3] * kr[3]); ssq = row16_sum(ssq);
            const float inv = 1.0f / fmaxf(sqrtf(ssq), 1e-12f);
            const f32x4 kk = kr * inv; const f32x4 ka = *(const f32x4*)(kaw + col);
            const f32x4 k = xk * (1.0f + (as - 1.0f) * ka);
            *(f32x4*)(R + off) = xr; *(f32x4*)(K + off) = k; *(f32x4*)(KK + off) = kk; *(f32x4*)(BV + off) = kk * as;
        }
    }
}


__device__ __forceinline__ void scan_load_chunk(const float* A0, const float* A1, const float* A2, const float* A3, const float* A4, const float* V, size_t base, int row0, int ch,
                                                LAS float* buf, LAS float* vbuf, int q) {
    constexpr int CH = 32;
    const int t0 = ch * CH;
    f32x4 t0v, t1v, t2v, t3v, t4v, t5v, t6v; float tv = 0.f;
#define SCAN_LD(i, dstv) { const int idx = q + 384 * (i); if (idx < 5 * CH * 16) { const int arr = idx >> 9, rem = idx & 511, st = rem >> 4, c4 = rem & 15; \
        const float* src = arr == 0 ? A0 : (arr == 1 ? A1 : (arr == 2 ? A2 : (arr == 3 ? A3 : A4))); dstv = *(const f32x4*)(src + base + (size_t)(t0 + st) * RW + c4 * 4); } }
    SCAN_LD(0, t0v) SCAN_LD(1, t1v) SCAN_LD(2, t2v) SCAN_LD(3, t3v) SCAN_LD(4, t4v) SCAN_LD(5, t5v) SCAN_LD(6, t6v)
#undef SCAN_LD
    if (q < 256) tv = V[base + (size_t)(t0 + (q >> 3)) * RW + row0 + (q & 7)];
#define SCAN_ST(i, srcv) { const int idx = q + 384 * (i); if (idx < 5 * CH * 16) *(LAS f32x4*)(buf + idx * 4) = srcv; }
    SCAN_ST(0, t0v) SCAN_ST(1, t1v) SCAN_ST(2, t2v) SCAN_ST(3, t3v) SCAN_ST(4, t4v) SCAN_ST(5, t5v) SCAN_ST(6, t6v)
#undef SCAN_ST
    if (q < 256) vbuf[q] = tv;
}
__device__ __forceinline__ void scan_phase(const Ctx& C) {
    CArgs* ap = get_args();
    unsigned char* ws = ap->ws;
    const float* ARR0 = (const float*)(ws + WS_R); const float* ARR1 = (const float*)(ws + WS_WDEC); const float* ARR2 = (const float*)(ws + WS_K);
    const float* ARR3 = (const float*)(ws + WS_KK); const float* ARR4 = (const float*)(ws + WS_BV); const float* V = (const float*)(ws + WS_VFIRST);
    float* YS = (float*)(ws + WS_YS);
    constexpr int CH = 32, NCH = TT / CH, BUF_F = 5 * CH * 64, VB_F = CH * 8;
    LAS float* buf = (LAS float*)C.lds;
    LAS float* vbuf = (LAS float*)C.lds + 2 * BUF_F;
    for (int task = C.bx; task < 256; task += C.G) {
        const int pair = task >> 3, b = pair >> 4, hd = pair & 15, row0 = (task & 7) * 8;
        const size_t base = (size_t)b * TT * RW + hd * 64;
        const int q = C.tid - 128;
        if (C.wave >= 2) scan_load_chunk(ARR0, ARR1, ARR2, ARR3, ARR4, V, base, row0, 0, buf, vbuf, q);
        __syncthreads();
        f32x4 S = (f32x4){0.f, 0.f, 0.f, 0.f};
        const int rr = C.wave * 4 + (C.lane >> 4), cgp = C.lane & 15;
        for (int ch = 0; ch < NCH; ++ch) {
            const int bi = ch & 1;
            if (C.wave >= 2) { if (ch + 1 < NCH) scan_load_chunk(ARR0, ARR1, ARR2, ARR3, ARR4, V, base, row0, ch + 1, buf + (bi ^ 1) * BUF_F, vbuf + (bi ^ 1) * VB_F, q); }
            else {
                const LAS float* bb = buf + bi * BUF_F + cgp * 4; const LAS float* vb = vbuf + bi * VB_F + rr;
                float* yp = YS + base + (size_t)(ch * CH) * RW + row0 + rr;
#pragma unroll 4
                for (int st = 0; st < CH; ++st) {
                    const f32x4 r4 = *(const LAS f32x4*)(bb + (0 * CH + st) * 64), w4 = *(const LAS f32x4*)(bb + (1 * CH + st) * 64), k4 = *(const LAS f32x4*)(bb + (2 * CH + st) * 64),
                                kk4 = *(const LAS f32x4*)(bb + (3 * CH + st) * 64), b4 = *(const LAS f32x4*)(bb + (4 * CH + st) * 64);
                    const float vi = vb[st * 8];
                    float sa = (S[0] * kk4[0] + S[1] * kk4[1]) + (S[2] * kk4[2] + S[3] * kk4[3]);
                    sa = -row16_sum(sa);
                    S = S * w4 + (b4 * sa + k4 * vi);
                    float y = (S[0] * r4[0] + S[1] * r4[1]) + (S[2] * r4[2] + S[3] * r4[3]);
                    y = row16_sum(y);
                    if (cgp == 0) yp[(size_t)st * RW] = y;
                }
            }
            __syncthreads();
        }
    }
}

__device__ __forceinline__ void post_phase(const Ctx& C, int l) {
    CArgs* ap = get_args();
    unsigned char* ws = ap->ws;
    const float* R = (const float*)(ws + WS_R); const float* K = (const float*)(ws + WS_K); const float* V = (const float*)(ws + WS_VFIRST); const float* YS = (const float*)(ws + WS_YS);
    const bf16* Gb = (const bf16*)(ws + WS_G); bf16* YR = (bf16*)(ws + WS_YRWKV);
    const float* OA = (const float*)(ws + WS_OATT); const float* LSE = (const float*)(ws + WS_LSE); bf16* YA = (bf16*)(ws + WS_YATT);
    const float* rk = ap->in[I_RK] + (size_t)l * RW; const float* lw = ap->in[I_LNXW] + (size_t)l * RW; const float* lb = ap->in[I_LNXB] + (size_t)l * RW;
    for (int row = C.gw; row < MROWS; row += C.NGW) {
#pragma unroll
        for (int i = 0; i < 4; ++i) { const int col = i * 256 + C.lane * 4; const size_t off = (size_t)row * RW + col;
            const f32x4 y = *(const f32x4*)(YS + off), r = *(const f32x4*)(R + off), k = *(const f32x4*)(K + off), v = *(const f32x4*)(V + off);
            const float mean = row16_sum((y[0] + y[1]) + (y[2] + y[3])) * (1.0f / 64.0f);
            const f32x4 d = y - mean;
            const float var = row16_sum((d[0] * d[0] + d[1] * d[1]) + (d[2] * d[2] + d[3] * d[3])) * (1.0f / 64.0f);
            const float rstd = rsqrtf(var + 64e-5f);
            const f32x4 rkk = r * k * *(const f32x4*)(rk + col);
            const float bonus = row16_sum((rkk[0] + rkk[1]) + (rkk[2] + rkk[3]));
            const f32x4 g = ld_bf4(Gb + off);
            const f32x4 o = (d * rstd * *(const f32x4*)(lw + col) + *(const f32x4*)(lb + col) + v * bonus) * g;
            u32x2 w; w.x = cvt_pk_bf16(o[0], o[1]); w.y = cvt_pk_bf16(o[2], o[3]); *(u32x2*)(YR + off) = w;
        }
        { const int hs = C.lane >> 4, d0 = (C.lane & 15) * 8;
            const float l0 = LSE[(size_t)row * 12 + hs], l1 = LSE[(size_t)row * 12 + 4 + hs], l2 = LSE[(size_t)row * 12 + 8 + hs];
            const float mx = fmaxf(l0, fmaxf(l1, l2)); float w0 = __expf(l0 - mx), w1 = __expf(l1 - mx), w2 = __expf(l2 - mx); const float inv = 1.0f / (w0 + w1 + w2); w0 *= inv; w1 *= inv; w2 *= inv;
            const float* o0 = OA + ((size_t)row * 12 + hs) * 128 + d0; const float* o1 = o0 + 4 * 128; const float* o2 = o0 + 8 * 128;
            const f32x4 x0 = *(const f32x4*)o0 * w0 + *(const f32x4*)o1 * w1 + *(const f32x4*)o2 * w2;
            const f32x4 x1 = *(const f32x4*)(o0 + 4) * w0 + *(const f32x4*)(o1 + 4) * w1 + *(const f32x4*)(o2 + 4) * w2;
            u32x4 w; w.x = cvt_pk_bf16(x0[0], x0[1]); w.y = cvt_pk_bf16(x0[2], x0[3]); w.z = cvt_pk_bf16(x1[0], x1[1]); w.w = cvt_pk_bf16(x1[2], x1[3]);
            *(u32x4*)(YA + (size_t)row * 512 + hs * 128 + d0) = w; }
    }
}
#define MFMA16(a_, b_, c_) __builtin_amdgcn_mfma_f32_16x16x32_bf16((a_), (b_), (c_), 0, 0, 0)
__device__ __forceinline__ void attn_phase(const Ctx& C) {
    CArgs* ap = get_args();
    const bf16* proj = (const bf16*)(ap->ws + WS_PROJ); float* OA = (float*)(ap->ws + WS_OATT); float* LSE = (float*)(ap->ws + WS_LSE);
    constexpr int KST = 136, VST = 264, PST = 264;
    LAS bf16* sK = (LAS bf16*)C.lds;
    LAS bf16* sP = (LAS bf16*)(C.lds + 69632) + C.wave * 16 * PST;
    const int fr = C.lane & 15, fq = C.lane >> 4;
    const float scale = 0.08838834764831845f, NEG = -__builtin_inff();
    for (int unit = C.bx; unit < 768; unit += C.G) {
        const int b = unit / 384, rem = unit % 384, h = rem >> 5, sub = rem & 31;
        const int g = h >> 2, dil = g == 0 ? 1 : (g == 1 ? 4 : 16), nbk = 32 / dil, r = sub / nbk, n = sub % nbk;
        const float slope = h < 8 ? exp2f(-0.5f * (float)(h + 1)) : exp2f(-(float)(h - 3));
        const size_t rowbase = (size_t)b * TT;
        const int qcol = PC_QKV + h * 128, kcol = PC_QKV + 1536 + h * 128, vcol = PC_QKV + 3072 + h * 128;
#pragma unroll
        for (int i = 0; i < 8; ++i) { const int idx = C.tid + 512 * i, j = idx >> 4, c8 = idx & 15, sk = (n - 1) * 128 + j;
            u32x4 val = (u32x4){0u, 0u, 0u, 0u};
            if (sk >= 0) val = *(const u32x4*)(proj + (rowbase + (size_t)sk * dil + r) * NPROJ + kcol + c8 * 8);
            *(LAS u32x4*)(sK + j * KST + c8 * 8) = val; }
        const size_t qtok = rowbase + (size_t)(n * 128 + C.wave * 16 + fr) * dil + r;
        bf16x8 qf[4];
#pragma unroll
        for (int ks = 0; ks < 4; ++ks) qf[ks] = *(const bf16x8*)(proj + qtok * NPROJ + qcol + ks * 32 + fq * 8);
        __syncthreads();
        f32x4 sc[16];
#pragma unroll
        for (int nt = 0; nt < 16; ++nt) { f32x4 acc = (f32x4){0.f, 0.f, 0.f, 0.f};
#pragma unroll
            for (int ks = 0; ks < 4; ++ks) { const bf16x8 kf = *(const LAS bf16x8*)(sK + (nt * 16 + fr) * KST + ks * 32 + fq * 8); acc = MFMA16(qf[ks], kf, acc); }
            sc[nt] = acc; }
        float mx[4] = {NEG, NEG, NEG, NEG};
#pragma unroll
        for (int nt = 0; nt < 16; ++nt)
#pragma unroll
            for (int rg = 0; rg < 4; ++rg) { const int i = C.wave * 16 + fq * 4 + rg, j = nt * 16 + fr, rel = 128 + i - j;
                const bool valid = rel >= 0 && rel <= 128 && (n > 0 || j >= 128);
                float s = sc[nt][rg] * scale - slope * (float)(rel * dil); s = valid ? s : NEG; sc[nt][rg] = s; mx[rg] = fmaxf(mx[rg], s); }
        float sum[4];
#pragma unroll
        for (int rg = 0; rg < 4; ++rg) { mx[rg] = row16_max(mx[rg]); sum[rg] = 0.f; }
#pragma unroll
        for (int nt = 0; nt < 16; ++nt)
#pragma unroll
            for (int rg = 0; rg < 4; ++rg) { const float p = __expf(sc[nt][rg] - mx[rg]); sum[rg] += p; sP[(fq * 4 + rg) * PST + nt * 16 + fr] = f2bf1(p); }
#pragma unroll
        for (int rg = 0; rg < 4; ++rg) sum[rg] = row16_sum(sum[rg]);
        __syncthreads();
#pragma unroll
        for (int i = 0; i < 8; ++i) { const int idx = C.tid + 512 * i, j = idx >> 4, c8 = idx & 15, sk = (n - 1) * 128 + j;
            u32x4 val = (u32x4){0u, 0u, 0u, 0u};
            if (sk >= 0) val = *(const u32x4*)(proj + (rowbase + (size_t)sk * dil + r) * NPROJ + vcol + c8 * 8);
            LAS bf16* dst = sK + (c8 * 8) * VST + j;
            dst[0 * VST] = (bf16)(val.x & 0xffffu); dst[1 * VST] = (bf16)(val.x >> 16); dst[2 * VST] = (bf16)(val.y & 0xffffu); dst[3 * VST] = (bf16)(val.y >> 16);
            dst[4 * VST] = (bf16)(val.z & 0xffffu); dst[5 * VST] = (bf16)(val.z >> 16); dst[6 * VST] = (bf16)(val.w & 0xffffu); dst[7 * VST] = (bf16)(val.w >> 16); }
        __syncthreads();
        bf16x8 pf[8];
#pragma unroll
        for (int ks = 0; ks < 8; ++ks) pf[ks] = *(const LAS bf16x8*)(sP + fr * PST + ks * 32 + fq * 8);
        float inv[4];
#pragma unroll
        for (int rg = 0; rg < 4; ++rg) inv[rg] = 1.0f / sum[rg];
#pragma unroll
        for (int nd = 0; nd < 8; ++nd) { f32x4 acc = (f32x4){0.f, 0.f, 0.f, 0.f};
#pragma unroll
            for (int ks = 0; ks < 8; ++ks) { const bf16x8 vf = *(const LAS bf16x8*)(sK + (nd * 16 + fr) * VST + ks * 32 + fq * 8); acc = MFMA16(pf[ks], vf, acc); }
#pragma unroll
            for (int rg = 0; rg < 4; ++rg) { const size_t tok = rowbase + (size_t)(n * 128 + C.wave * 16 + fq * 4 + rg) * dil + r;
                OA[(tok * 12 + h) * 128 + nd * 16 + fr] = acc[rg] * inv[rg]; } }
        if (fr == 0) {
#pragma unroll
            for (int rg = 0; rg < 4; ++rg) { const size_t tok = rowbase + (size_t)(n * 128 + C.wave * 16 + fq * 4 + rg) * dil + r; LSE[tok * 12 + h] = mx[rg] + __logf(sum[rg]); } }
        __syncthreads();
    }
}

__device__ __forceinline__ void sgu_phase(const Ctx& C, int l) {
    CArgs* ap = get_args();
    const bf16* proj = (const bf16*)(ap->ws + WS_PROJ); bf16* YS_ = (bf16*)(ap->ws + WS_YSGU);
    const float* lng = ap->in[I_SLNG] + (size_t)l * 512; const float* lnb = ap->in[I_SLNB] + (size_t)l * 512;
    const float* wsrc = ap->in[I_SWS] + (size_t)l * 4 * 128 * 128; const float* bsrc = ap->in[I_SB] + (size_t)l * 4 * 128;
    constexpr int ST = 136;
    LAS bf16* sV = (LAS bf16*)C.lds; LAS bf16* sW = (LAS bf16*)(C.lds + 34816); LAS float* stat = (LAS float*)(C.lds + 69632);
    const int fr = C.lane & 15, fq = C.lane >> 4;
    for (int unit = C.bx; unit < 256; unit += C.G) {
        const int g = unit & 3; const size_t t0 = (size_t)(unit >> 2) * 128;
        for (int i = 0; i < 16; ++i) { const int tok = C.wave * 16 + i;
            const u32x4 raw = *(const u32x4*)(proj + (t0 + tok) * NPROJ + PC_SGU + 512 + C.lane * 8);
            const float x0 = bflo(raw.x), x1 = bfhi(raw.x), x2 = bflo(raw.y), x3 = bfhi(raw.y), x4 = bflo(raw.z), x5 = bfhi(raw.z), x6 = bflo(raw.w), x7 = bfhi(raw.w);
            float s = ((x0 + x1) + (x2 + x3)) + ((x4 + x5) + (x6 + x7)); float q = ((x0 * x0 + x1 * x1) + (x2 * x2 + x3 * x3)) + ((x4 * x4 + x5 * x5) + (x6 * x6 + x7 * x7));
            s = wave_sum(s); q = wave_sum(q); const float mean = s * (1.0f / 512.0f); const float var = fmaxf(q * (1.0f / 512.0f) - mean * mean, 0.f);
            if (C.lane == 0) { stat[tok * 2] = mean; stat[tok * 2 + 1] = rsqrtf(var + 1e-5f); } }
        __syncthreads();
#pragma unroll
        for (int i = 0; i < 4; ++i) { const int idx = C.tid + 512 * i, s = idx >> 4, c8 = idx & 15;
            const u32x4 raw = *(const u32x4*)(proj + (t0 + s) * NPROJ + PC_SGU + 512 + g * 128 + c8 * 8);
            const float mean = stat[s * 2], rstd = stat[s * 2 + 1];
            float x[8] = {bflo(raw.x), bfhi(raw.x), bflo(raw.y), bfhi(raw.y), bflo(raw.z), bfhi(raw.z), bflo(raw.w), bfhi(raw.w)};
#pragma unroll
            for (int e = 0; e < 8; ++e) { const int d = c8 * 8 + e; sV[d * ST + s] = f2bf1((x[e] - mean) * rstd * lng[g * 128 + d] + lnb[g * 128 + d]); } }
#pragma unroll
        for (int i = 0; i < 8; ++i) { const int idx = C.tid + 512 * i, t = idx >> 5, s4 = idx & 31;
            f32x4 w = *(const f32x4*)(wsrc + ((size_t)g * 128 + t) * 128 + s4 * 4);
#pragma unroll
            for (int e = 0; e < 4; ++e) if (s4 * 4 + e > t) w[e] = 0.f;
            u32x2 o; o.x = cvt_pk_bf16(w[0], w[1]); o.y = cvt_pk_bf16(w[2], w[3]); *(LAS u32x2*)(sW + t * ST + s4 * 4) = o; }
        __syncthreads();
        bf16x8 wf[4];
#pragma unroll
        for (int ks = 0; ks < 4; ++ks) wf[ks] = *(const LAS bf16x8*)(sW + (C.wave * 16 + fr) * ST + ks * 32 + fq * 8);
#pragma unroll
        for (int nd = 0; nd < 8; ++nd) { f32x4 acc = (f32x4){0.f, 0.f, 0.f, 0.f};
#pragma unroll
            for (int ks = 0; ks < 4; ++ks) { const bf16x8 vf = *(const LAS bf16x8*)(sV + (nd * 16 + fr) * ST + ks * 32 + fq * 8); acc = MFMA16(wf[ks], vf, acc); }
#pragma unroll
            for (int rg = 0; rg < 4; ++rg) { const int t = C.wave * 16 + fq * 4 + rg, d = nd * 16 + fr;
                const float mixed = acc[rg] + bsrc[g * 128 + t]; const float u = bf2f(proj[(t0 + t) * NPROJ + PC_SGU + g * 128 + d]);
                YS_[(t0 + t) * 512 + g * 128 + d] = f2bf1(u * mixed); } }
        __syncthreads();
    }
}


__device__ __forceinline__ void lora_phase(const Ctx& C, int l) {
    CArgs* ap = get_args(); unsigned char* ws = ap->ws;
    const bf16* A = (const bf16*)(ws + WS_ALORA); const bf16* Wl = (const bf16*)(ws + WS_WLORA);
    const int fr = C.lane & 15, fq = C.lane >> 4;
    const int nblk = l == 0 ? 3 : 4, nitems = 512 * nblk * 8;
    for (int it = C.gw; it < nitems; it += C.NGW) {
        const int cg = it & 7, rb = (it >> 3) & 511, blk = it >> 12;
        const int k0 = blk == 0 ? 0 : (blk == 1 ? 64 : (blk == 2 ? 128 : 288)), nk = blk == 2 ? 5 : (blk == 3 ? 1 : 2);
        f32x4 acc[8];
#pragma unroll
        for (int j = 0; j < 8; ++j) acc[j] = (f32x4){0.f, 0.f, 0.f, 0.f};
        const bf16* ap0 = A + (size_t)(rb * 16 + fr) * KLORA + k0 + fq * 8;
        const bf16* bp0 = Wl + (size_t)(blk * 1024 + cg * 128 + fr) * KLORA + k0 + fq * 8;
        for (int ks = 0; ks < nk; ++ks) {
            const bf16x8 af = *(const bf16x8*)(ap0 + ks * 32);
#pragma unroll
            for (int j = 0; j < 8; ++j) { const bf16x8 bf = *(const bf16x8*)(bp0 + (size_t)j * 16 * KLORA + ks * 32); acc[j] = MFMA16(af, bf, acc[j]); }
        }
        const float* bias = blk == 0 ? ap->in[I_DW0] + (size_t)l * RW : (blk == 1 ? ap->in[I_A0] + (size_t)l * RW : ap->in[I_VV0]);
        float* dstf = (float*)(ws + (blk == 0 ? WS_WDEC : (blk == 1 ? WS_ASIG : WS_VG))); bf16* dstb = (bf16*)(ws + WS_G);
#pragma unroll
        for (int j = 0; j < 8; ++j) { const int col = cg * 128 + j * 16 + fr; const float bv = blk == 2 ? 0.f : bias[col];
#pragma unroll
            for (int rg = 0; rg < 4; ++rg) { const size_t off = (size_t)(rb * 16 + fq * 4 + rg) * RW + col; float v = acc[j][rg] + bv;
                if (blk == 2) dstb[off] = f2bf1(v);
                else { if (blk == 0) { const float z = -v; const float sp = fmaxf(z, 0.f) + __logf(1.0f + __expf(-fabsf(z))); v = __expf(-__expf(-sp - 0.5f)); } else v = sigmoidf_(v);
                    dstf[off] = v; } } }
    }
}

template <class Epi> __device__ __forceinline__ void run_gemm(const Ctx& C, const bf16* A, const bf16* Bt, int M, int N, int K, const Epi& E) {
#ifdef ZERO_LDS
    for (int i = C.tid; i < 131072 / 16; i += 512) *(LAS u32x4*)(C.lds + i * 16) = (u32x4){0u, 0u, 0u, 0u};
    __syncthreads();
#endif
    pg8::Gemm g{A, Bt, M, N, K}; pg8::StaticOrder S; S.init(M, N, C.G, (int)C.bx);
    pg8::gemm_phase<Epi, pg8::StaticOrder, GEMM_ALIGN, GEMM_SP2>(C.lds, g, S, E, C.tid);
}

__device__ __forceinline__ Ctx make_ctx(unsigned char* lds_raw, int wave0) {
    Ctx C; int ln; asm volatile("v_mbcnt_lo_u32_b32 %0, -1, 0\n\tv_mbcnt_hi_u32_b32 %0, -1, %0" : "=v"(ln)); int t = wave0 * 64 + ln; int bx = blockIdx.x; asm volatile("" : "+s"(bx));
    C.lds = (LAS unsigned char*)lds_raw; C.tid = t; C.lane = t & 63; C.wave = __builtin_amdgcn_readfirstlane(t >> 6);
    C.G = gridDim.x; C.bx = bx; C.gw = bx * 8 + C.wave; C.NGW = C.G * 8; return C;
}

__device__ __forceinline__ void grid_barrier(unsigned* bar, unsigned target) {
    asm volatile("s_waitcnt vmcnt(0) lgkmcnt(0)" ::: "memory");
    __syncthreads();
    if (threadIdx.x == 0) {
        __builtin_amdgcn_fence(__ATOMIC_RELEASE, "agent");
        asm volatile("s_waitcnt vmcnt(0)" ::: "memory");
        __hip_atomic_fetch_add(bar, 1u, __ATOMIC_RELAXED, __HIP_MEMORY_SCOPE_AGENT);
        while (__hip_atomic_load(bar, __ATOMIC_RELAXED, __HIP_MEMORY_SCOPE_AGENT) < target) __builtin_amdgcn_s_sleep(2);
#ifdef BAR_DELAY
        { const unsigned long long t0 = __builtin_amdgcn_s_memrealtime(); while (__builtin_amdgcn_s_memrealtime() - t0 < 5000ull) __builtin_amdgcn_s_sleep(8); }
#endif
        __builtin_amdgcn_fence(__ATOMIC_ACQUIRE, "agent");
        asm volatile("s_waitcnt vmcnt(0)" ::: "memory");
    }
    __syncthreads();
}

#ifdef STOPK
__device__ __forceinline__ void dump_u32(float* out, const unsigned char* srcb, size_t nwords, bool first) {
    const unsigned* src = (const unsigned*)srcb;
    for (size_t i = (size_t)blockIdx.x * 512 + threadIdx.x; i < (size_t)MROWS * DM; i += (size_t)gridDim.x * 512) {
        const unsigned w = src[i % nwords]; const unsigned hh = (w ^ (w >> 15)) * 2654435761u; const float v = (float)((hh ^ (hh >> 13)) * 2246822519u >> 8) * (1.0f / 16777216.0f);
        out[i] = first ? v : out[i] + v; }
}
#ifndef STOPL
#define STOPL 1
#endif
#define STOP_AT(k, ...) if (l == STOPL && STOPK == (k)) { CArgs* ap = get_args(); unsigned char* ws = ap->ws; float* out = ap->out; __VA_ARGS__; return; }
#else
#define STOP_AT(k, ...)
#endif

#ifdef STOPK
__device__ __forceinline__ void sum_region(const unsigned char* srcb, size_t ld, size_t w0, size_t nw, size_t nrows, unsigned* acc) {
    const unsigned* src = (const unsigned*)srcb; unsigned part = 0u;
    for (size_t i = (size_t)blockIdx.x * 512 + threadIdx.x; i < nw * nrows; i += (size_t)gridDim.x * 512) {
        const size_t r = i / nw, c = i % nw; const unsigned w = src[r * ld + w0 + c]; const unsigned hh = (w ^ (w >> 15)) * 2654435761u + (unsigned)i * 40503u; part += (hh ^ (hh >> 13)) * 2246822519u; }
    atomicAdd(acc, part);
}
__device__ __forceinline__ void bcast_sum(float* out, unsigned* acc, unsigned target) {
    grid_barrier(acc - 64, target);
    const unsigned tot = __hip_atomic_load(acc, __ATOMIC_RELAXED, __HIP_MEMORY_SCOPE_AGENT);
    for (size_t i = (size_t)blockIdx.x * 512 + threadIdx.x; i < (size_t)MROWS * DM; i += (size_t)gridDim.x * 512) {
        const unsigned hh = (tot + (unsigned)i) * 2654435761u; out[i] = (float)((hh ^ (hh >> 13)) * 2246822519u >> 8) * (1.0f / 16777216.0f); }
}
#define ANYBIT(k, ...) if (l == STOPL && STOPK == (k)) { CArgs* ap = get_args(); unsigned char* ws = ap->ws; unsigned* acc = (unsigned*)ws + 64; __VA_ARGS__; bcast_sum(ap->out, acc, (unsigned)(++bar_idx) * gridDim.x); return; }
#else
#define ANYBIT(k, ...)
#endif
#define PH_BEGIN if (pidx >= ph_lo && pidx < ph_hi) { CArgs* ap = get_args(); unsigned char* ws = ap->ws; (void)ws; const Ctx C = make_ctx(lds_raw, wave0);
#define PH_END } if (pidx >= ph_lo && pidx + 1 < ph_hi) grid_barrier((unsigned*)get_args()->ws, (unsigned)(++bar_idx) * gridDim.x); ++pidx;
#define WSB(off) ((bf16*)(ws + (off)))
#define WSF(off) ((float*)(ws + (off)))
template <int l> __device__ __forceinline__ void layer_body(unsigned char* lds_raw, const int wave0, int& bar_idx, int& pidx, const int ph_lo, const int ph_hi) {
        PH_BEGIN run_gemm(C, WSB(WS_XN), WSB(WS_WGU1), MROWS, 2 * FF, DM, EpiSwiglu{WSB(WS_ACT)}); PH_END
        STOP_AT(1, dump_u32(out, ws + WS_ACT, (size_t)MROWS * FF / 2, true))
        ANYBIT(101, sum_region(ws + WS_ACT, FF / 2, 0, FF / 2, MROWS, acc))
        PH_BEGIN run_gemm(C, WSB(WS_ACT), WSB(WS_WD1), MROWS, DM, FF, EpiF32{WSF(WS_YF), DM}); PH_END
        STOP_AT(2, dump_u32(out, ws + WS_YF, (size_t)MROWS * DM, true))
        ANYBIT(102, sum_region(ws + WS_YF, DM, 0, DM, MROWS, acc))
        PH_BEGIN norm_phase(C, WSF(WS_YF), ap->in[I_F1POST] + (size_t)l * DM, 0.5f, l == 0 ? ap->in[I_X] : ap->out, ap->out, ap->in[I_MIXPRE] + (size_t)l * DM, WSB(WS_XN)); PH_END
        STOP_AT(3, dump_u32(out, ws + WS_XN, (size_t)MROWS * DM / 2, true))
        ANYBIT(103, sum_region(ws + WS_XN, DM / 2, 0, DM / 2, MROWS, acc); sum_region((const unsigned char*)ap->out, DM, 0, DM, MROWS, acc))
#ifdef STOP_L1_P3
        if (l == 1) return;
#endif
        PH_BEGIN run_gemm(C, WSB(WS_XN), WSB(WS_WIN), MROWS, NPROJ, DM, EpiProj{WSB(WS_PROJ)}); PH_END
        STOP_AT(4, dump_u32(out, ws + WS_PROJ, (size_t)MROWS * NPROJ / 2, true))
        ANYBIT(104, sum_region(ws + WS_PROJ, NPROJ / 2, 1536, 160, MROWS, acc))
        ANYBIT(105, sum_region(ws + WS_PROJ, NPROJ / 2, 0, NPROJ / 2, MROWS, acc))
        STOP_AT(41, dump_u32(out, ws + WS_PROJ + 64 * MiB, (size_t)44 * MiB, true); dump_u32(out, ws + WS_PROJ + 176 * MiB, (size_t)16 * MiB, false))
        STOP_AT(42, dump_u32(out, ws + WS_PROJ + 128 * MiB, (size_t)28 * MiB, true))
        STOP_AT(43, dump_u32(out, ws + WS_PROJ + 176 * MiB, (size_t)16 * MiB, true))
#ifdef ONLY_LORAA
        PH_BEGIN loraA_phase(C, l); PH_END
#else
        PH_BEGIN loraA_phase(C, l); attn_phase(C); sgu_phase(C, l); PH_END
#endif
        STOP_AT(5, dump_u32(out, ws + WS_ALORA, (size_t)MROWS * KLORA / 2, true))
        ANYBIT(106, sum_region(ws + WS_ALORA, KLORA / 2, 0, KLORA / 2, MROWS, acc))
        ANYBIT(107, sum_region(ws + WS_OATT, 1536, 0, 1536, MROWS, acc); sum_region(ws + WS_LSE, 12, 0, 12, MROWS, acc); sum_region(ws + WS_YSGU, 256, 0, 256, MROWS, acc))
#ifdef SKIP_LORA0
        PH_BEGIN if (l == 1) lora_phase(C, l); PH_END
#else
        PH_BEGIN lora_phase(C, l); PH_END
#endif
        ANYBIT(108, sum_region(ws + WS_WDEC, RW, 0, RW, MROWS, acc); sum_region(ws + WS_ASIG, RW, 0, RW, MROWS, acc); sum_region(ws + WS_G, RW / 2, 0, RW / 2, MROWS, acc); if (l > 0) sum_region(ws + WS_VG, RW, 0, RW, MROWS, acc))
        STOP_AT(6, dump_u32(out, ws + 824 * MiB, (size_t)MROWS * RW / 2, true))
        STOP_AT(62, dump_u32(out, ws + WS_G, (size_t)MROWS * RW / 2, true))
        STOP_AT(61, dump_u32(out, ws + WS_WDEC, (size_t)MROWS * RW, true); dump_u32(out, ws + WS_ASIG, (size_t)MROWS * RW, false); dump_u32(out, ws + WS_VG, (size_t)MROWS * RW, false))
        PH_BEGIN prep_phase(C, l); PH_END
        ANYBIT(109, sum_region(ws + WS_R, RW, 0, RW, MROWS, acc); sum_region(ws + WS_K, RW, 0, RW, MROWS, acc); sum_region(ws + WS_KK, RW, 0, RW, MROWS, acc); sum_region(ws + WS_BV, RW, 0, RW, MROWS, acc); sum_region(ws + WS_VFIRST, RW, 0, RW, MROWS, acc))
        STOP_AT(7, dump_u32(out, ws + WS_R, (size_t)MROWS * RW, true); dump_u32(out, ws + WS_K, (size_t)MROWS * RW, false); dump_u32(out, ws + WS_KK, (size_t)MROWS * RW, false); dump_u32(out, ws + WS_BV, (size_t)MROWS * RW, false); dump_u32(out, ws + WS_VFIRST, (size_t)MROWS * RW, false))
        PH_BEGIN scan_phase(C); PH_END
        ANYBIT(110, sum_region(ws + WS_YS, RW, 0, RW, MROWS, acc))
        STOP_AT(8, dump_u32(out, ws + WS_YS, (size_t)MROWS * RW, true))
        PH_BEGIN post_phase(C, l); PH_END
        ANYBIT(111, sum_region(ws + WS_YRWKV, RW / 2, 0, RW / 2, MROWS, acc); sum_region(ws + WS_YATT, 256, 0, 256, MROWS, acc))
        STOP_AT(9, dump_u32(out, ws + WS_YRWKV, (size_t)MROWS * RW / 2, true); dump_u32(out, ws + WS_YATT, (size_t)MROWS * 512 / 2, false))
        if (pidx >= ph_lo && pidx < ph_hi) { { CArgs* ap = get_args(); unsigned char* ws = ap->ws; const Ctx C = make_ctx(lds_raw, wave0); run_gemm(C, WSB(WS_YRWKV), WSB(WS_WBR_R), MROWS, DM, RW, EpiMerge<0>{WSF(WS_MERGED_F32), WSB(WS_MERGED_BF), WSB(WS_PROJ) + PC_GATE}); }
          { CArgs* ap = get_args(); unsigned char* ws = ap->ws; const Ctx C = make_ctx(lds_raw, wave0); run_gemm(C, WSB(WS_YATT), WSB(WS_WBR_A), MROWS, DM, 512, EpiMerge<1>{WSF(WS_MERGED_F32), WSB(WS_MERGED_BF), WSB(WS_PROJ) + PC_GATE + 2048}); }
          { CArgs* ap = get_args(); unsigned char* ws = ap->ws; const Ctx C = make_ctx(lds_raw, wave0); run_gemm(C, WSB(WS_YSGU), WSB(WS_WBR_S), MROWS, DM, 512, EpiMerge<2>{WSF(WS_MERGED_F32), WSB(WS_MERGED_BF), WSB(WS_PROJ) + PC_GATE + 4096}); } }
        if (pidx >= ph_lo && pidx + 1 < ph_hi) grid_barrier((unsigned*)get_args()->ws, (unsigned)(++bar_idx) * gridDim.x); ++pidx;
        ANYBIT(112, sum_region(ws + WS_MERGED_BF, DM / 2, 0, DM / 2, MROWS, acc))
        PH_BEGIN run_gemm(C, WSB(WS_MERGED_BF), WSB(WS_WOUT), MROWS, DM, DM, EpiF32{WSF(WS_Y), DM}); PH_END
        STOP_AT(11, dump_u32(out, ws + WS_Y, (size_t)MROWS * DM, true))
        ANYBIT(113, sum_region(ws + WS_Y, DM, 0, DM, MROWS, acc))
        PH_BEGIN norm_phase(C, WSF(WS_Y), ap->in[I_MIXPOST] + (size_t)l * DM, 1.0f, ap->out, ap->out, ap->in[I_F2PRE] + (size_t)l * DM, WSB(WS_XN)); PH_END
        ANYBIT(114, sum_region(ws + WS_XN, DM / 2, 0, DM / 2, MROWS, acc); sum_region((const unsigned char*)ap->out, DM, 0, DM, MROWS, acc))
#ifdef STOP_L1_P12
        if (l == 1) return;
#endif
        PH_BEGIN run_gemm(C, WSB(WS_XN), WSB(WS_WGU2), MROWS, 2 * FF, DM, EpiSwiglu{WSB(WS_ACT)}); PH_END
        PH_BEGIN run_gemm(C, WSB(WS_ACT), WSB(WS_WD2), MROWS, DM, FF, EpiF32{WSF(WS_YF), DM}); PH_END
        PH_BEGIN norm_phase(C, WSF(WS_YF), ap->in[I_F2POST] + (size_t)l * DM, 0.5f, ap->out, ap->out, l == 0 ? ap->in[I_F1PRE] + DM : (const float*)nullptr, WSB(WS_XN));
#ifndef SKIP_CONV1
                 if (l == 0) convert_phase(C, 1);
#endif
                 PH_END
}

__global__ void __launch_bounds__(512, 2) mega(Args a_) {
    extern __shared__ __attribute__((aligned(16))) unsigned char lds_raw[];
    cg::grid_group grid = cg::this_grid();
    const int wave0 = __builtin_amdgcn_readfirstlane((int)threadIdx.x >> 6);
    int bar_idx = 0, pidx = 0; const int ph_lo = a_.ph_lo, ph_hi = a_.ph_hi;
    grid.sync();
    PH_BEGIN convert_phase(C, 0); prenorm_phase(C, ap->in[I_X], ap->in[I_F1PRE], WSB(WS_XN)); PH_END
#if defined(STOPK) && STOPK == 100
    { CArgs* ap = get_args(); unsigned char* ws = ap->ws; unsigned* acc = (unsigned*)ws + 64; sum_region(ws + WS_XN, DM / 2, 0, DM / 2, MROWS, acc); sum_region(ws + MiB, 1, 0, 1, (size_t)208 * MiB / 4, acc); bcast_sum(ap->out, acc, (unsigned)(++bar_idx) * gridDim.x); return; }
#endif
#if defined(STOPK) && STOPK == 0
    { CArgs* ap = get_args(); dump_u32(ap->out, ap->ws + WS_XN, (size_t)MROWS * DM / 2, true); return; }
#endif
#if defined(STOPK) && STOPK == 51
    { CArgs* ap = get_args(); dump_u32(ap->out, ap->ws + WS_WGU1, (size_t)2 * FF * DM / 2, true); return; }
#endif
#if defined(STOPK) && STOPK == 50
    { CArgs* ap = get_args(); dump_u32(ap->out, (const unsigned char*)ap->in[I_X], (size_t)MROWS * DM, true); return; }
#endif
    layer_body<0>(lds_raw, wave0, bar_idx, pidx, ph_lo, ph_hi);
#if !defined(STOP_L0) && !(defined(STOPK) && defined(STOPL) && STOPL == 0)
    layer_body<1>(lds_raw, wave0, bar_idx, pidx, ph_lo, ph_hi);
#endif
#ifdef DUMP_INPUTS
    { grid_barrier((unsigned*)get_args()->ws, (unsigned)(++bar_idx) * gridDim.x); CArgs* ap = get_args();
      dump_u32(ap->out, (const unsigned char*)ap->in[I_SHMU], 6720, true); dump_u32(ap->out, (const unsigned char*)ap->in[I_VMU], 32, false); dump_u32(ap->out, (const unsigned char*)ap->in[I_VV0], 1024, false); dump_u32(ap->out, (const unsigned char*)ap->in[I_VW2], 32768, false); }
#endif
}

extern "C" void kernel_launch(void* const* d_in, const int* in_sizes, int n_in, void* d_out, int out_size, void* d_ws, size_t ws_size, hipStream_t stream) {
    static int grid = 0;
    if (!grid) {
        int dev = 0, cus = 0, per_cu = 0;
        (void)hipGetDevice(&dev);
        (void)hipDeviceGetAttribute(&cus, hipDeviceAttributeMultiprocessorCount, dev);
        (void)hipFuncSetAttribute((const void*)mega, hipFuncAttributeMaxDynamicSharedMemorySize, LDS_BYTES);
        (void)hipOccupancyMaxActiveBlocksPerMultiprocessor(&per_cu, (const void*)mega, 512, LDS_BYTES);
        if (per_cu < 1) per_cu = 1;
        grid = cus * per_cu;
        if (n_in != N_INPUTS || out_size != MROWS * DM || ws_size < WS_END) { fprintf(stderr, "kernel_launch: unexpected sizes n_in %d out %d ws %zu\n", n_in, out_size, ws_size); grid = -1; }
    }
    if (grid < 0) return;
    Args a{};
    for (int i = 0; i < N_INPUTS; ++i) a.in[i] = (const float*)d_in[i];
    a.out = (float*)d_out; a.ws = (unsigned char*)d_ws;
#ifndef N_PHASES_PER_LAUNCH
#define N_PHASES_PER_LAUNCH 64
#endif
    constexpr int TOTAL_PH = 31;
    for (int lo = 0; lo < TOTAL_PH; lo += N_PHASES_PER_LAUNCH) {
        (void)hipMemsetAsync(d_ws, 0, 4096, stream);
        a.ph_lo = lo; a.ph_hi = lo + N_PHASES_PER_LAUNCH < TOTAL_PH ? lo + N_PHASES_PER_LAUNCH : TOTAL_PH;
        void* args[] = {&a};
        hipError_t e = hipLaunchCooperativeKernel((void*)mega, dim3(grid), dim3(512), args, LDS_BYTES, stream);
        if (e != hipSuccess) { fprintf(stderr, "cooperative launch failed: %s (grid %d)\n", hipGetErrorString(e), grid); break; }
    }
}
```

```cpp
#define GEMM_ALIGN true
#define GEMM_SP2 true
#include <hip/hip_runtime.h>
#include <hip/hip_cooperative_groups.h>
#include <cstdio>
#include <cstdint>
namespace cg = cooperative_groups;
namespace pg8 {
#define PG8_LAS __attribute__((address_space(3)))
typedef unsigned short bf16_t;
typedef short bf16x8 __attribute__((ext_vector_type(8)));
typedef float f32x4 __attribute__((ext_vector_type(4)));
typedef unsigned u32x4 __attribute__((ext_vector_type(4)));
constexpr int BM = 256, BK = 64, HALF = 128, HTB = HALF * BK * 2  , STAGE_BYTES = 8 * HTB, NXCD = 8, WGM = 8;

__host__ __device__ __forceinline__ int lds_byte(int r, int c) { const int st = (r >> 4) * 2 + (c >> 5), rr = r & 15, cc = c & 31, ob = rr * 64 + cc * 2; return st * 1024 + (ob ^ (((ob >> 9) & 1) << 5)); }
__host__ __device__ __forceinline__ void stage_rc(int b, int& R, int& C) { const int st = b / 1024, sb = b % 1024, swz = sb ^ (((sb >> 9) & 1) << 5); R = (st >> 1) * 16 + swz / 64; C = (st & 1) * 32 + (swz % 64) / 2; }
__host__ __device__ __forceinline__ int perm32(int rho) { const int n = rho >> 4, i = rho & 15; return 8 * (i >> 2) + 4 * n + (i & 3); }

struct Unit { int pm, pn; };
struct Gemm { const bf16_t* A; const bf16_t* Bt; int M, N, K; };

struct StaticOrder {
    int nM, nN, nwg, G, c;
    __host__ __device__ void init(int M, int N, int G_, int c_) { nM = M / BM; nN = N / BM; nwg = nM * nN; G = G_; c = c_; }
    __host__ __device__ bool next(int i, Unit& u) const {
        const long L = (long)i * G + c; if (L >= nwg) return false;
        int wgid = (int)L; { const int q = nwg / NXCD, r = nwg % NXCD, xcd = wgid % NXCD, off = wgid / NXCD; wgid = (xcd < r ? xcd * (q + 1) : r * (q + 1) + (xcd - r) * q) + off; }
        const int nig = WGM * nN, gid = wgid / nig, fm = gid * WGM, gsz = (nM - fm) < WGM ? (nM - fm) : WGM;
        u.pm = fm + ((wgid % nig) % gsz); u.pn = (wgid % nig) / gsz; return true;
    }
    __device__ __forceinline__ void a_ready(const Unit&) const {}
    __device__ __forceinline__ void done(const Unit&) const {}
};
__device__ __forceinline__ unsigned cvt_pk_bf16(float lo, float hi) { unsigned r; asm volatile("v_cvt_pk_bf16_f32 %0, %1, %2" : "=v"(r) : "v"(lo), "v"(hi)); return r; }
typedef float f32x2 __attribute__((ext_vector_type(2)));
template <class Epi, class Sched, bool ALIGN_EPI = false, bool SP2 = false>
__device__ __forceinline__ void gemm_phase(PG8_LAS unsigned char* lds, const Gemm g, const Sched& S, const Epi& E, int tid_in) {
    int tid_ = tid_in; asm volatile("" : "+v"(tid_));
    const int tid = tid_, wid = __builtin_amdgcn_readfirstlane(tid >> 6), lane = tid & 63, wr = wid >> 2, wc = wid & 3, fr = lane & 15, fq = lane >> 4;
    const int K = g.K, nt = K / BK;
    unsigned voffA[2], voffB[2];
#pragma unroll
    for (int i = 0; i < 2; ++i) { int R, C; stage_rc(tid * 16 + i * 8192, R, C); const int Rb = Epi::PERM ? ((R & ~31) + perm32(R & 31)) : R;
        voffA[i] = (unsigned)(R * K + C) * 2u; voffB[i] = (unsigned)(Rb * K + C) * 2u; }
    const size_t kstep = (size_t)(BK * 2);
    const size_t hstep = (size_t)HALF * K * 2;
    const size_t tstep = 2 * hstep;
    const unsigned ldsw = (unsigned)wid * 1024u;
    const int aoff = lds_byte(wr * 64 + fr, fq * 8), boff = lds_byte(wc * 32 + fr, fq * 8);
#define PG8_SA(b, h) (((b) * 2 + (h)) * HTB)
#define PG8_SB(b, h) ((4 + (b) * 2 + (h)) * HTB)
#define PG8_STAGE(bufoff, gbase, voff) do { _Pragma("unroll") for (int _i = 0; _i < 2; ++_i) \
        __builtin_amdgcn_global_load_lds((const unsigned*)((const char*)(gbase) + (voff)[_i]), (PG8_LAS unsigned*)(lds + (bufoff) + ldsw + _i * 8192), 16, 0, 0); } while (0)
#define PG8_LDA(dst, b, h) do { _Pragma("unroll") for (int m = 0; m < 4; ++m) _Pragma("unroll") for (int k = 0; k < 2; ++k) dst[m][k] = *(const PG8_LAS bf16x8*)(lds + PG8_SA(b, h) + aoff + m * 2048 + k * 1024); } while (0)
#define PG8_LDB(dst, b, h) do { _Pragma("unroll") for (int n = 0; n < 2; ++n) _Pragma("unroll") for (int k = 0; k < 2; ++k) dst[n][k] = *(const PG8_LAS bf16x8*)(lds + PG8_SB(b, h) + boff + n * 2048 + k * 1024); } while (0)
#define PG8_MMA(ai, bj, At, Bt) do { __builtin_amdgcn_s_setprio(1); _Pragma("unroll") for (int m = 0; m < 4; ++m) _Pragma("unroll") for (int n = 0; n < 2; ++n) _Pragma("unroll") for (int k = 0; k < 2; ++k) \
        acc[ai][bj][m][n] = __builtin_amdgcn_mfma_f32_16x16x32_bf16(Bt[n][k], At[m][k], acc[ai][bj][m][n], 0, 0, 0); __builtin_amdgcn_s_setprio(0); } while (0)
#ifdef DRAIN_ALL
#define PG8_WAIT_V(n) asm volatile("s_waitcnt vmcnt(0)" ::: "memory")
#else
#define PG8_WAIT_V(n) asm volatile("s_waitcnt vmcnt(" #n ")" ::: "memory")
#endif
#define PG8_WAIT_L(n) asm volatile("s_waitcnt lgkmcnt(" #n ")" ::: "memory")
#define PG8_BAR __builtin_amdgcn_s_barrier()
#define PG8_SCHED __builtin_amdgcn_sched_barrier(0)
    Unit cur, nxt; int ui = 0;
    if (!S.next(0, cur)) return;
    f32x4 acc[2][2][4][2];
#pragma unroll
    for (int a = 0; a < 2; ++a)
#pragma unroll
        for (int b = 0; b < 2; ++b)
#pragma unroll
            for (int m = 0; m < 4; ++m)
#pragma unroll
                for (int n = 0; n < 2; ++n) acc[a][b][m][n] = (f32x4){0.f, 0.f, 0.f, 0.f};
    bf16x8 At[4][2], B0[2][2], B1[2][2];
    const char* cA = (const char*)g.A + (size_t)cur.pm * tstep; const char* cB = (const char*)g.Bt + (size_t)cur.pn * tstep;
    S.a_ready(cur);
    if constexpr (SP2) {
        PG8_STAGE(PG8_SB(0, 0), cB, voffB); PG8_STAGE(PG8_SB(0, 1), cB + hstep, voffB); PG8_STAGE(PG8_SA(0, 0), cA, voffA); PG8_STAGE(PG8_SA(0, 1), cA + hstep, voffA);
        if (wr == 1) PG8_BAR;
        PG8_WAIT_V(2); PG8_BAR;
        PG8_STAGE(PG8_SB(1, 0), cB + kstep, voffB); PG8_STAGE(PG8_SA(1, 0), cA + kstep, voffA); PG8_STAGE(PG8_SB(1, 1), cB + hstep + kstep, voffB);
        PG8_WAIT_V(6); PG8_BAR;
    } else {
        PG8_STAGE(PG8_SB(0, 0), cB, voffB); PG8_STAGE(PG8_SA(0, 0), cA, voffA); PG8_STAGE(PG8_SB(0, 1), cB + hstep, voffB); PG8_STAGE(PG8_SA(0, 1), cA + hstep, voffA);
        if (wr == 1) PG8_BAR;
        PG8_WAIT_V(4); PG8_BAR;
        PG8_STAGE(PG8_SB(1, 0), cB + kstep, voffB); PG8_STAGE(PG8_SA(1, 0), cA + kstep, voffA); PG8_STAGE(PG8_SB(1, 1), cB + hstep + kstep, voffB);
        PG8_WAIT_V(6); PG8_BAR;
    }
    for (;;) {
        const bool has_next = S.next(ui + 1, nxt);
        const char* nA = has_next ? (const char*)g.A + (size_t)nxt.pm * tstep : cA; const char* nB = has_next ? (const char*)g.Bt + (size_t)nxt.pn * tstep : cB;
        for (int t = 0; t < nt; t += 2) {
            const bool last = (t == nt - 2);
            const char* a1 = cA + (size_t)(t + 1) * kstep;
            const char* a2 = last ? nA : cA + (size_t)(t + 2) * kstep; const char* b2 = last ? nB : cB + (size_t)(t + 2) * kstep;
            const char* a3 = a2 + kstep; const char* b3 = b2 + kstep;
            if (last && has_next) S.a_ready(nxt);
            if constexpr (SP2) {
            PG8_LDB(B0, 0, 0); PG8_LDB(B1, 0, 1); PG8_SCHED; PG8_LDA(At, 0, 0); PG8_STAGE(PG8_SA(1, 1), a1 + hstep, voffA);
            PG8_WAIT_V(8); PG8_WAIT_L(0); PG8_BAR; PG8_MMA(0, 0, At, B0); PG8_MMA(0, 1, At, B1); PG8_BAR; PG8_SCHED;
            PG8_LDA(At, 0, 1); PG8_STAGE(PG8_SB(0, 0), b2, voffB); PG8_STAGE(PG8_SB(0, 1), b2 + hstep, voffB); PG8_STAGE(PG8_SA(0, 0), a2, voffA);
            PG8_WAIT_V(8); PG8_WAIT_L(0); PG8_BAR; PG8_MMA(1, 0, At, B0); PG8_MMA(1, 1, At, B1); PG8_BAR; PG8_SCHED;
            PG8_LDB(B0, 1, 0); PG8_LDB(B1, 1, 1); PG8_SCHED; PG8_LDA(At, 1, 0); PG8_STAGE(PG8_SA(0, 1), a2 + hstep, voffA);
            PG8_WAIT_V(8); PG8_WAIT_L(0); PG8_BAR; PG8_MMA(0, 0, At, B0); PG8_MMA(0, 1, At, B1); PG8_BAR; PG8_SCHED;
            PG8_LDA(At, 1, 1); PG8_STAGE(PG8_SB(1, 0), b3, voffB); PG8_STAGE(PG8_SB(1, 1), b3 + hstep, voffB); PG8_STAGE(PG8_SA(1, 0), a3, voffA);
            PG8_WAIT_V(8); PG8_WAIT_L(0); PG8_BAR; PG8_MMA(1, 0, At, B0); PG8_MMA(1, 1, At, B1); PG8_BAR; PG8_SCHED;
            } else {
            PG8_LDB(B0, 0, 0); PG8_SCHED; PG8_LDA(At, 0, 0); PG8_STAGE(PG8_SA(1, 1), a1 + hstep, voffA);
            PG8_WAIT_L(8); PG8_BAR; PG8_WAIT_L(0); PG8_MMA(0, 0, At, B0); PG8_BAR; PG8_SCHED;
            PG8_LDB(B1, 0, 1); PG8_STAGE(PG8_SB(0, 0), b2, voffB);
            PG8_BAR; PG8_WAIT_L(0); PG8_MMA(0, 1, At, B1); PG8_BAR;
            PG8_LDA(At, 0, 1); PG8_STAGE(PG8_SA(0, 0), a2, voffA);
            PG8_BAR; PG8_WAIT_L(0); PG8_MMA(1, 0, At, B0); PG8_BAR; PG8_SCHED;
            PG8_STAGE(PG8_SB(0, 1), b2 + hstep, voffB);
            PG8_WAIT_V(6); PG8_BAR; PG8_MMA(1, 1, At, B1); PG8_BAR;
            PG8_LDB(B0, 1, 0); PG8_SCHED; PG8_LDA(At, 1, 0); PG8_STAGE(PG8_SA(0, 1), a2 + hstep, voffA);
            PG8_WAIT_L(8); PG8_BAR; PG8_WAIT_L(0); PG8_MMA(0, 0, At, B0); PG8_BAR; PG8_SCHED;
            PG8_LDB(B1, 1, 1); PG8_STAGE(PG8_SB(1, 0), b3, voffB);
            PG8_BAR; PG8_WAIT_L(0); PG8_MMA(0, 1, At, B1); PG8_BAR;
            PG8_LDA(At, 1, 1); PG8_STAGE(PG8_SA(1, 0), a3, voffA);
            PG8_BAR; PG8_WAIT_L(0); PG8_MMA(1, 0, At, B0); PG8_BAR; PG8_SCHED;
            PG8_STAGE(PG8_SB(1, 1), b3 + hstep, voffB);
            PG8_WAIT_V(6); PG8_BAR; PG8_MMA(1, 1, At, B1); PG8_BAR;
            }
        }
        if constexpr (ALIGN_EPI) { if (wr == 0) PG8_BAR; }
        if constexpr (!Epi::AFTER_DRAIN) { E(acc, cur, wr, wc, fr, fq); S.done(cur); }
        if (!has_next) break;
#pragma unroll
        for (int a = 0; a < 2; ++a)
#pragma unroll
            for (int b = 0; b < 2; ++b)
#pragma unroll
                for (int m = 0; m < 4; ++m)
#pragma unroll
                    for (int n = 0; n < 2; ++n) acc[a][b][m][n] = (f32x4){0.f, 0.f, 0.f, 0.f};
        cur = nxt; cA = nA; cB = nB; ++ui;
        if constexpr (ALIGN_EPI) { if (wr == 1) PG8_BAR; }
    }
    PG8_WAIT_V(0);
    if constexpr (!ALIGN_EPI) { if (wr == 0) PG8_BAR; }
    PG8_BAR;
    if constexpr (Epi::AFTER_DRAIN) { E.fused(acc, cur, wr, wc, fr, fq, lds, wid, lane); S.done(cur); }
#undef PG8_SA
#undef PG8_SB
#undef PG8_STAGE
#undef PG8_LDA
#undef PG8_LDB
#undef PG8_MMA
#undef PG8_WAIT_V
#undef PG8_WAIT_L
#undef PG8_BAR
#undef PG8_SCHED
}
}
#define LAS __attribute__((address_space(3)))
typedef unsigned short bf16;
typedef pg8::f32x4 f32x4;
typedef pg8::bf16x8 bf16x8;
typedef pg8::u32x4 u32x4;
typedef unsigned u32x2 __attribute__((ext_vector_type(2)));
using pg8::cvt_pk_bf16;

constexpr int TT = 4096, MROWS = 8192, DM = 2048, FF = 5504, RW = 1024;
constexpr int NPROJ = 15360, PC_PV = 3360, PC_QKV = 3584, PC_SGU = 8192, PC_GATE = 9216;
constexpr int KLORA = 384;
constexpr size_t MiB = 1u << 20;
constexpr size_t WS_WGU1 = 1 * MiB, WS_WD1 = 44 * MiB, WS_WIN = 65 * MiB + MiB / 2, WS_WBR_R = 125 * MiB + MiB / 2, WS_WBR_A = 129 * MiB + MiB / 2,
                 WS_WBR_S = 131 * MiB + MiB / 2, WS_WOUT = 133 * MiB + MiB / 2, WS_WGU2 = 141 * MiB + MiB / 2, WS_WD2 = 184 * MiB + MiB / 2, WS_WLORA = 206 * MiB,
                 WS_XN = 209 * MiB, WS_VFIRST = 241 * MiB, WS_U = 273 * MiB;
constexpr size_t WS_PROJ = WS_U, WS_ACT = WS_U, WS_YF = WS_U + 96 * MiB;
constexpr size_t WS_R = 513 * MiB, WS_K = 545 * MiB, WS_KK = 577 * MiB, WS_BV = 609 * MiB, WS_WDEC = 641 * MiB, WS_ASIG = 673 * MiB, WS_VG = 705 * MiB, WS_G = 737 * MiB,
                 WS_ALORA = 753 * MiB, WS_OATT = 759 * MiB, WS_LSE = 807 * MiB, WS_YSGU = 808 * MiB, WS_YATT = 816 * MiB, WS_END = 824 * MiB;
constexpr size_t WS_MERGED_F32 = WS_R, WS_MERGED_BF = WS_KK, WS_Y = WS_BV, WS_YS = WS_ASIG, WS_YRWKV = WS_VG;
constexpr int LDS_BYTES = 147456;

enum { I_X = 0, I_F1PRE, I_F1GU, I_F1DN, I_F1POST, I_MIXPRE, I_WIN, I_SHMU, I_DW0, I_DW2, I_A0, I_A2, I_G2, I_KK, I_KA, I_RK, I_LNXW, I_LNXB,
       I_VW1, I_VMU, I_VV0, I_VW2, I_SLNG, I_SLNB, I_SWS, I_SB, I_WBR, I_WBA, I_WBS, I_WOUT, I_MIXPOST, I_F2PRE, I_F2GU, I_F2DN, I_F2POST, N_INPUTS };
struct Args { const float* in[N_INPUTS]; float* out; unsigned char* ws; int ph_lo, ph_hi; };
typedef const __attribute__((address_space(4))) Args CArgs;
__device__ __forceinline__ CArgs* get_args() { CArgs* p = (CArgs*)__builtin_amdgcn_kernarg_segment_ptr(); asm volatile("" : "+s"(p)); return p; }

__device__ __forceinline__ float bf2f(unsigned v) { return __uint_as_float(v << 16); }
__device__ __forceinline__ float bflo(unsigned w) { return __uint_as_float(w << 16); }
__device__ __forceinline__ float bfhi(unsigned w) { return __uint_as_float(w & 0xffff0000u); }
__device__ __forceinline__ unsigned short f2bf1(float f) { return (unsigned short)(cvt_pk_bf16(f, 0.f) & 0xffffu); }
__device__ __forceinline__ float sigmoidf_(float x) { return __builtin_amdgcn_rcpf(1.0f + __expf(-x)); }
__device__ __forceinline__ float tanhf_(float x) { return 2.0f * sigmoidf_(2.0f * x) - 1.0f; }
__device__ __forceinline__ float siluf_(float x) { return x * sigmoidf_(x); }
__device__ __forceinline__ float gelutf_(float x) { const float u = 0.7978845608028654f * (x + 0.044715f * x * x * x); return x * sigmoidf_(2.0f * u); }
template <int CTRL> __device__ __forceinline__ float dppf(float x) { return __builtin_bit_cast(float, __builtin_amdgcn_mov_dpp(__builtin_bit_cast(int, x), CTRL, 0xf, 0xf, true)); }
__device__ __forceinline__ float row16_sum(float x) { x += dppf<0xB1>(x); x += dppf<0x4E>(x); x += dppf<0x141>(x); x += dppf<0x128>(x); return x; }
__device__ __forceinline__ float row16_max(float x) { x = fmaxf(x, dppf<0xB1>(x)); x = fmaxf(x, dppf<0x4E>(x)); x = fmaxf(x, dppf<0x141>(x)); x = fmaxf(x, dppf<0x128>(x)); return x; }
__device__ __forceinline__ float wave_sum(float v) {
    v = row16_sum(v);
    const int iv = __builtin_bit_cast(int, v);
    const float s0 = __builtin_bit_cast(float, __builtin_amdgcn_readlane(iv, 0)), s1 = __builtin_bit_cast(float, __builtin_amdgcn_readlane(iv, 16)),
                s2 = __builtin_bit_cast(float, __builtin_amdgcn_readlane(iv, 32)), s3 = __builtin_bit_cast(float, __builtin_amdgcn_readlane(iv, 48));
    return (s0 + s1) + (s2 + s3);
}
#define LDS_WAIT() asm volatile("s_waitcnt lgkmcnt(0)" ::: "memory")

using pg8::Unit; using pg8::BM; using pg8::HALF;
struct EpiSwiglu {
    static constexpr bool PERM = true, AFTER_DRAIN = false;
    bf16* O;
    __device__ __forceinline__ void operator()(const f32x4 (&acc)[2][2][4][2], const Unit& u, int wr, int wc, int fr, int fq) const {
        const int row0 = u.pm * BM + wr * 64 + fr, col0 = u.pn * 128 + wc * 32 + 8 * fq;
#pragma unroll
        for (int ai = 0; ai < 2; ++ai)
#pragma unroll
            for (int m = 0; m < 4; ++m) {
                bf16* rowp = O + (size_t)(row0 + ai * HALF + m * 16) * FF + col0;
                const f32x4 g0 = acc[ai][0][m][0], g1 = acc[ai][0][m][1], u0 = acc[ai][1][m][0], u1 = acc[ai][1][m][1];
                u32x4 w;
                w.x = cvt_pk_bf16(siluf_(g0[0]) * u0[0], siluf_(g0[1]) * u0[1]); w.y = cvt_pk_bf16(siluf_(g0[2]) * u0[2], siluf_(g0[3]) * u0[3]);
                w.z = cvt_pk_bf16(siluf_(g1[0]) * u1[0], siluf_(g1[1]) * u1[1]); w.w = cvt_pk_bf16(siluf_(g1[2]) * u1[2], siluf_(g1[3]) * u1[3]);
                *(u32x4*)rowp = w;
            }
    }
};
struct EpiF32 {
    static constexpr bool PERM = false, AFTER_DRAIN = false;
    float* C; int ldc;
    __device__ __forceinline__ void operator()(const f32x4 (&acc)[2][2][4][2], const Unit& u, int wr, int wc, int fr, int fq) const {
        const int row0 = u.pm * BM + wr * 64 + fr, col0 = u.pn * BM + wc * 32 + 4 * fq;
#pragma unroll
        for (int ai = 0; ai < 2; ++ai)
#pragma unroll
            for (int m = 0; m < 4; ++m) { float* rowp = C + (size_t)(row0 + ai * HALF + m * 16) * ldc + col0;
#pragma unroll
                for (int bj = 0; bj < 2; ++bj)
#pragma unroll
                    for (int n = 0; n < 2; ++n) *(f32x4*)(rowp + bj * HALF + n * 16) = acc[ai][bj][m][n]; }
    }
};
struct EpiProj {
    static constexpr bool PERM = true, AFTER_DRAIN = false;
    bf16* O; int ldc;
    __device__ __forceinline__ void operator()(const f32x4 (&acc)[2][2][4][2], const Unit& u, int wr, int wc, int fr, int fq) const {
        const int row0 = u.pm * BM + wr * 64 + fr, col0 = u.pn * BM + wc * 32 + 8 * fq;
        const int mode = u.pn < 32 ? 0 : (u.pn < 36 ? 1 : 2);
#pragma unroll
        for (int ai = 0; ai < 2; ++ai)
#pragma unroll
            for (int m = 0; m < 4; ++m) { bf16* rowp = O + (size_t)(row0 + ai * HALF + m * 16) * ldc + col0;
#pragma unroll
                for (int bj = 0; bj < 2; ++bj) { f32x4 v0 = acc[ai][bj][m][0], v1 = acc[ai][bj][m][1];
                    if (mode == 1) {
#pragma unroll
                        for (int j = 0; j < 4; ++j) { v0[j] = gelutf_(v0[j]); v1[j] = gelutf_(v1[j]); } }
                    else if (mode == 2) {
#pragma unroll
                        for (int j = 0; j < 4; ++j) { v0[j] = sigmoidf_(v0[j]); v1[j] = sigmoidf_(v1[j]); } }
                    u32x4 w; w.x = cvt_pk_bf16(v0[0], v0[1]); w.y = cvt_pk_bf16(v0[2], v0[3]); w.z = cvt_pk_bf16(v1[0], v1[1]); w.w = cvt_pk_bf16(v1[2], v1[3]);
                    *(u32x4*)(rowp + bj * HALF) = w; } }
    }
};
template <int MODE> __device__ __forceinline__ void lora_store(const f32x4 (&acc)[2][2][4][2], int row0, int col0, const float* bias, float* dstf, bf16* dstb) {
#pragma unroll
    for (int ai = 0; ai < 2; ++ai)
#pragma unroll
        for (int m = 0; m < 4; ++m) { const size_t roff = (size_t)(row0 + ai * HALF + m * 16) * RW;
#pragma unroll
            for (int bj = 0; bj < 2; ++bj)
#pragma unroll
                for (int n = 0; n < 2; ++n) { const int col = col0 + bj * HALF + n * 16; f32x4 v = acc[ai][bj][m][n];
                    if (MODE == 2) { u32x2 w; w.x = cvt_pk_bf16(v[0], v[1]); w.y = cvt_pk_bf16(v[2], v[3]); *(u32x2*)(dstb + roff + col) = w; }
                    else { v = v + *(const f32x4*)(bias + col);
                        if (MODE == 0) {
#pragma unroll
                            for (int j = 0; j < 4; ++j) { const float z = -v[j]; const float sp = fmaxf(z, 0.f) + __logf(1.0f + __expf(-fabsf(z))); v[j] = __expf(-__expf(-sp - 0.5f)); } }
                        else {
#pragma unroll
                            for (int j = 0; j < 4; ++j) v[j] = sigmoidf_(v[j]); }
                        *(f32x4*)(dstf + roff + col) = v; } }
            asm volatile("" ::: "memory"); }
}
struct EpiLora {
    static constexpr bool PERM = false, AFTER_DRAIN = false;
    int l;
    __device__ __forceinline__ void operator()(const f32x4 (&acc)[2][2][4][2], const Unit& u, int wr, int wc, int fr, int fq) const {
        CArgs* ap = get_args(); unsigned char* ws = ap->ws;
        const int row0 = u.pm * BM + wr * 64 + fr; const int blk = u.pn >> 2; const int col0 = (u.pn & 3) * BM + wc * 32 + 4 * fq;
        if (blk == 0) lora_store<0>(acc, row0, col0, ap->in[I_DW0] + (size_t)l * RW, (float*)(ws + WS_WDEC), nullptr);
        else if (blk == 1) lora_store<1>(acc, row0, col0, ap->in[I_A0] + (size_t)l * RW, (float*)(ws + WS_ASIG), nullptr);
        else if (blk == 2) lora_store<2>(acc, row0, col0, nullptr, nullptr, (bf16*)(ws + WS_G));
        else lora_store<1>(acc, row0, col0, ap->in[I_VV0], (float*)(ws + WS_VG), nullptr);
    }
};
template <int PASS> struct EpiMerge {
    static constexpr bool PERM = false, AFTER_DRAIN = false;
    bf16* Mp; bf16* Mb; const bf16* gate;
    __device__ __forceinline__ void operator()(const f32x4 (&acc)[2][2][4][2], const Unit& u, int wr, int wc, int fr, int fq) const {
        const int row0 = u.pm * BM + wr * 64 + fr, col0 = u.pn * BM + wc * 32 + 4 * fq;
#pragma unroll
        for (int ai = 0; ai < 2; ++ai)
#pragma unroll
            for (int m = 0; m < 4; ++m) { const int row = row0 + ai * HALF + m * 16;
#pragma unroll
                for (int bj = 0; bj < 2; ++bj)
#pragma unroll
                    for (int n = 0; n < 2; ++n) { const int col = col0 + bj * HALF + n * 16; const size_t off = (size_t)row * DM + col;
                        const u32x2 gw = *(const u32x2*)(gate + (size_t)row * NPROJ + col);
                        f32x4 g; g[0] = bflo(gw.x); g[1] = bfhi(gw.x); g[2] = bflo(gw.y); g[3] = bfhi(gw.y);
                        f32x4 v = acc[ai][bj][m][n] * g;
                        if (PASS > 0) { const u32x2 pw = *(const u32x2*)(Mp + off); f32x4 pv; pv[0] = bflo(pw.x); pv[1] = bfhi(pw.x); pv[2] = bflo(pw.y); pv[3] = bfhi(pw.y); v = v + pv; }
                        u32x2 w; w.x = cvt_pk_bf16(v[0], v[1]); w.y = cvt_pk_bf16(v[2], v[3]);
                        *(u32x2*)((PASS < 2 ? Mp : Mb) + off) = w; } }
    }
};
__device__ __forceinline__ f32x4 ld_bf4(const bf16* p) { const u32x2 w = *(const u32x2*)p; f32x4 r; r[0] = bflo(w.x); r[1] = bfhi(w.x); r[2] = bflo(w.y); r[3] = bfhi(w.y); return r; }
struct Ctx { LAS unsigned char* lds; int tid, lane, wave, G, bx, gw, NGW; };

__device__ __forceinline__ void tr_item(const float* src, int ldn, int sc0, int k0, bf16* dst, int Kd, int dr0, LAS float* scr, int lane, bool zero) {
    const int c = lane & 7;
    if (zero) {
#pragma unroll
        for (int j = 0; j < 4; ++j) { const int n = (lane >> 3) + 8 * j; *(u32x4*)(dst + (size_t)(dr0 + n) * Kd + k0 + 8 * c) = (u32x4){0u, 0u, 0u, 0u}; }
        return;
    }
    float tv[32];
#pragma unroll
    for (int i = 0; i < 32; ++i) { const int kk = 2 * i + (lane >> 5); tv[i] = src[(size_t)(k0 + kk) * ldn + sc0 + (lane & 31)]; }
#pragma unroll
    for (int i = 0; i < 32; ++i) { const int kk = 2 * i + (lane >> 5); scr[kk * 33 + (lane & 31)] = tv[i]; }
    LDS_WAIT(); asm volatile("" ::: "memory");
#pragma unroll
    for (int j = 0; j < 4; ++j) { const int n = (lane >> 3) + 8 * j; const LAS float* s = scr + (8 * c) * 33 + n;
        u32x4 o; o.x = cvt_pk_bf16(s[0 * 33], s[1 * 33]); o.y = cvt_pk_bf16(s[2 * 33], s[3 * 33]); o.z = cvt_pk_bf16(s[4 * 33], s[5 * 33]); o.w = cvt_pk_bf16(s[6 * 33], s[7 * 33]);
        *(u32x4*)(dst + (size_t)(dr0 + n) * Kd + k0 + 8 * c) = o; }
    LDS_WAIT(); asm volatile("" ::: "memory");
}
__device__ __forceinline__ void convert_phase(const Ctx& C, int l, int mask) {
    CArgs* ap = get_args();
    unsigned char* ws = ap->ws;
    LAS float* scr = (LAS float*)(C.lds + C.wave * 8704);
    constexpr int N_GU = (2 * FF / 32) * (DM / 64), N_DN = (DM / 32) * (FF / 64), N_IN = (NPROJ / 32) * (DM / 64), N_BR = (DM / 32) * (RW / 64), N_BA = (DM / 32) * (512 / 64), N_WO = (DM / 32) * (DM / 64);
    constexpr int TOTAL = 2 * N_GU + 2 * N_DN + N_IN + N_BR + 2 * N_BA + N_WO;
    for (int it = C.gw; it < TOTAL; it += C.NGW) {
        int r = it;
        if (r < 2 * N_GU) {
            const int which = r >= N_GU; if (which) r -= N_GU;
            if (!(mask & (which ? 16 : 1))) continue;
            const float* src = ap->in[which ? I_F2GU : I_F1GU] + (size_t)l * DM * 2 * FF; bf16* dst = (bf16*)(ws + (which ? WS_WGU2 : WS_WGU1));
            const int nblk = 2 * FF / 32, nb = r % nblk, kb = r / nblk, rho0 = 32 * nb; const int pn = rho0 >> 8, bj = (rho0 >> 7) & 1, i0 = rho0 & 127;
            tr_item(src, 2 * FF, bj * FF + 128 * pn + i0, 64 * kb, dst, DM, rho0, scr, C.lane, false); continue; }
        r -= 2 * N_GU;
        if (r < 2 * N_DN) {
            const int which = r >= N_DN; if (which) r -= N_DN;
            if (!(mask & (which ? 2 : 4))) continue;
            const float* src = ap->in[which ? I_F2DN : I_F1DN] + (size_t)l * FF * DM; bf16* dst = (bf16*)(ws + (which ? WS_WD2 : WS_WD1));
            const int nblk = DM / 32, nb = r % nblk, kb = r / nblk;
            tr_item(src, DM, 32 * nb, 64 * kb, dst, FF, 32 * nb, scr, C.lane, false); continue; }
        r -= 2 * N_DN;
        if (r < N_IN) {
            if (!(mask & 8)) continue;
            const int nblk = NPROJ / 32, nb = r % nblk, kb = r / nblk, rho0 = 32 * nb; bf16* dst = (bf16*)(ws + WS_WIN);
            if (rho0 < PC_PV) tr_item(ap->in[I_WIN] + (size_t)l * DM * 15136, 15136, rho0, 64 * kb, dst, DM, rho0, scr, C.lane, false);
            else if (rho0 == PC_PV) tr_item(ap->in[I_VW1], 32, 0, 64 * kb, dst, DM, rho0, scr, C.lane, l == 0);
            else if (rho0 < PC_QKV) tr_item(ap->in[I_WIN], 15136, 0, 64 * kb, dst, DM, rho0, scr, C.lane, true);
            else tr_item(ap->in[I_WIN] + (size_t)l * DM * 15136, 15136, rho0 - 224, 64 * kb, dst, DM, rho0, scr, C.lane, false);
            continue; }
        r -= N_IN;
        if (!(mask & 2)) continue;
        if (r < N_BR) { const int nblk = DM / 32, nb = r % nblk, kb = r / nblk;
            tr_item(ap->in[I_WBR] + (size_t)l * RW * DM, DM, 32 * nb, 64 * kb, (bf16*)(ws + WS_WBR_R), RW, 32 * nb, scr, C.lane, false); continue; }
        r -= N_BR;
        if (r < 2 * N_BA) { const int which = r >= N_BA; if (which) r -= N_BA; const int nblk = DM / 32, nb = r % nblk, kb = r / nblk;
            tr_item(ap->in[which ? I_WBS : I_WBA] + (size_t)l * 512 * DM, DM, 32 * nb, 64 * kb, (bf16*)(ws + (which ? WS_WBR_S : WS_WBR_A)), 512, 32 * nb, scr, C.lane, false); continue; }
        r -= 2 * N_BA;
        { const int nblk = DM / 32, nb = r % nblk, kb = r / nblk;
            tr_item(ap->in[I_WOUT] + (size_t)l * DM * DM, DM, 32 * nb, 64 * kb, (bf16*)(ws + WS_WOUT), DM, 32 * nb, scr, C.lane, false); }
    }
    bf16* wl = (bf16*)(ws + WS_WLORA);
    if (mask & 8) for (int idx = C.bx * 512 + C.tid; idx < 4096 * KLORA; idx += C.G * 512) {
        const int n = idx & 1023, rest = idx >> 10, k = rest % KLORA, blk = rest / KLORA;
        float v = 0.f;
        if (blk == 0) { if (k < 64) v = ap->in[I_DW2][(size_t)l * 64 * RW + (size_t)k * RW + n]; }
        else if (blk == 1) { if (k >= 64 && k < 128) v = ap->in[I_A2][(size_t)l * 64 * RW + (size_t)(k - 64) * RW + n]; }
        else if (blk == 2) { if (k >= 128 && k < 288) v = ap->in[I_G2][(size_t)l * 160 * RW + (size_t)(k - 128) * RW + n]; }
        else { if (l > 0 && k >= 288 && k < 320) v = ap->in[I_VW2][(size_t)(k - 288) * RW + n]; }
        wl[(size_t)(blk * 1024 + n) * KLORA + k] = f2bf1(v);
    }
}

__device__ __forceinline__ void prenorm_phase(const Ctx& C, const float* x, const float* g, bf16* xn) {
    for (int row = C.gw; row < MROWS; row += C.NGW) {
        const f32x4* xr = (const f32x4*)(x + (size_t)row * DM) + C.lane; f32x4 v[8]; float ss = 0.f;
#pragma unroll
        for (int j = 0; j < 8; ++j) { v[j] = xr[64 * j]; ss += (v[j][0] * v[j][0] + v[j][1] * v[j][1]) + (v[j][2] * v[j][2] + v[j][3] * v[j][3]); }
        const float rs = rsqrtf(wave_sum(ss) * (1.0f / DM) + 1e-6f);
        u32x2* o = (u32x2*)(xn + (size_t)row * DM) + C.lane;
#pragma unroll
        for (int j = 0; j < 8; ++j) { const f32x4 gg = ((const f32x4*)g)[C.lane + 64 * j]; u32x2 w; w.x = cvt_pk_bf16(v[j][0] * rs * gg[0], v[j][1] * rs * gg[1]); w.y = cvt_pk_bf16(v[j][2] * rs * gg[2], v[j][3] * rs * gg[3]); o[64 * j] = w; }
    }
}
template <bool HIN_BF, bool HOUT_BF>
__device__ __forceinline__ void norm_phase(const Ctx& C, const bf16* y, const float* post_g, float fac, const void* h_in, void* h_out, const float* pre_g, bf16* xn) {
    for (int row = C.gw; row < MROWS; row += C.NGW) {
        const bf16* yr = y + (size_t)row * DM + C.lane * 4;
        f32x4 v[8]; float ss = 0.f;
#pragma unroll
        for (int j = 0; j < 8; ++j) { v[j] = ld_bf4(yr + 256 * j); ss += (v[j][0] * v[j][0] + v[j][1] * v[j][1]) + (v[j][2] * v[j][2] + v[j][3] * v[j][3]); }
        const float rs = rsqrtf(wave_sum(ss) * (1.0f / DM) + 1e-6f) * fac;
        float s2 = 0.f;
#pragma unroll
        for (int j = 0; j < 8; ++j) { const f32x4 gg = ((const f32x4*)post_g)[C.lane + 64 * j];
            f32x4 hh;
            if (HIN_BF) hh = ld_bf4((const bf16*)h_in + (size_t)row * DM + C.lane * 4 + 256 * j); else hh = ((const f32x4*)((const float*)h_in + (size_t)row * DM))[C.lane + 64 * j];
            v[j] = hh + v[j] * rs * gg;
            if (HOUT_BF) { u32x2 w; w.x = cvt_pk_bf16(v[j][0], v[j][1]); w.y = cvt_pk_bf16(v[j][2], v[j][3]); *(u32x2*)((bf16*)h_out + (size_t)row * DM + C.lane * 4 + 256 * j) = w;
                v[j][0] = bflo(w.x); v[j][1] = bfhi(w.x); v[j][2] = bflo(w.y); v[j][3] = bfhi(w.y); }
            else ((f32x4*)((float*)h_out + (size_t)row * DM))[C.lane + 64 * j] = v[j];
            s2 += (v[j][0] * v[j][0] + v[j][1] * v[j][1]) + (v[j][2] * v[j][2] + v[j][3] * v[j][3]); }
        if (pre_g) {
            const float r2 = rsqrtf(wave_sum(s2) * (1.0f / DM) + 1e-6f);
            u32x2* o = (u32x2*)(xn + (size_t)row * DM) + C.lane;
#pragma unroll
            for (int j = 0; j < 8; ++j) { const f32x4 gg = ((const f32x4*)pre_g)[C.lane + 64 * j]; u32x2 w; w.x = cvt_pk_bf16(v[j][0] * r2 * gg[0], v[j][1] * r2 * gg[1]); w.y = cvt_pk_bf16(v[j][2] * r2 * gg[2], v[j][3] * r2 * gg[3]); o[64 * j] = w; }
        }
    }
}

__device__ __forceinline__ void loraA_phase(const Ctx& C, int l) {
    CArgs* ap = get_args();
    const bf16* proj = (const bf16*)(ap->ws + WS_PROJ); bf16* A = (bf16*)(ap->ws + WS_ALORA);
    const float* mu = ap->in[I_SHMU] + (size_t)l * 3360;
    for (int row = C.gw; row < MROWS; row += C.NGW) {
        const bool first = (row % TT) == 0;
        const bf16* p1 = proj + (size_t)row * NPROJ + 3072; const bf16* p0 = proj + (size_t)(first ? row : row - 1) * NPROJ + 3072;
        bf16* arow = A + (size_t)row * KLORA;
#pragma unroll
        for (int h = 0; h < 2; ++h) { const int g = C.lane + 64 * h;
            if (g < 96) { const int c = 4 * g; f32x4 val = (f32x4){0.f, 0.f, 0.f, 0.f};
                if (c < 320) {
                    const f32x4 p = ld_bf4(p1 + c); f32x4 pp = ld_bf4(p0 + c); if (first) pp = (f32x4){0.f, 0.f, 0.f, 0.f};
                    f32x4 m = (f32x4){0.f, 0.f, 0.f, 0.f};
                    if (c < 288) m = *(const f32x4*)(mu + 3072 + c); else if (l > 0) m = *(const f32x4*)(ap->in[I_VMU] + (c - 288));
                    const f32x4 sv = p + (pp - p) * m;
#pragma unroll
                    for (int e = 0; e < 4; ++e) val[e] = c < 64 ? tanhf_(sv[e]) : (c < 128 ? sv[e] : (c < 288 ? sigmoidf_(sv[e]) : (l > 0 ? sv[e] : 0.f)));
                }
                u32x2 w; w.x = cvt_pk_bf16(val[0], val[1]); w.y = cvt_pk_bf16(val[2], val[3]); *(u32x2*)(arow + c) = w; } }
    }
}

__device__ __forceinline__ void prep_phase(const Ctx& C, int l) {
    CArgs* ap = get_args();
    unsigned char* ws = ap->ws; const bf16* proj = (const bf16*)(ws + WS_PROJ);
    float* R = (float*)(ws + WS_R); float* K = (float*)(ws + WS_K); float* KK = (float*)(ws + WS_KK); float* BV = (float*)(ws + WS_BV); float* V = (float*)(ws + WS_VFIRST);
    const float* AS = (const float*)(ws + WS_ASIG); const float* VG = (const float*)(ws + WS_VG);
    const float* mu = ap->in[I_SHMU] + (size_t)l * 3360; const float* kkw = ap->in[I_KK] + (size_t)l * RW; const float* kaw = ap->in[I_KA] + (size_t)l * RW;
    for (int row = C.gw; row < MROWS; row += C.NGW) {
        const bool first = (row % TT) == 0; const bf16* p1 = proj + (size_t)row * NPROJ; const bf16* p0 = proj + (size_t)(first ? row : row - 1) * NPROJ;
#pragma unroll
        for (int i = 0; i < 4; ++i) { const int col = i * 256 + C.lane * 4; const size_t off = (size_t)row * RW + col;
            f32x4 xr = ld_bf4(p1 + col), xk = ld_bf4(p1 + 1024 + col), xv = ld_bf4(p1 + 2048 + col);
            f32x4 qr = ld_bf4(p0 + col), qk = ld_bf4(p0 + 1024 + col), qv = ld_bf4(p0 + 2048 + col);
            if (first) { qr = (f32x4){0.f, 0.f, 0.f, 0.f}; qk = qr; qv = qr; }
            xr = xr + (qr - xr) * *(const f32x4*)(mu + col); xk = xk + (qk - xk) * *(const f32x4*)(mu + 1024 + col); xv = xv + (qv - xv) * *(const f32x4*)(mu + 2048 + col);
            f32x4 v = xv;
            if (l > 0) { const f32x4 vf = *(const f32x4*)(V + off), vg = *(const f32x4*)(VG + off); v = xv + (vf - xv) * vg; }
            *(f32x4*)(V + off) = v;
            const f32x4 as = *(const f32x4*)(AS + off);
            const f32x4 kr = xk * *(const f32x4*)(kkw + col);
            float ssq = (kr[0] * kr[0] + kr[1] * kr[1]) + (kr[2] * kr[2] + kr[3] * kr[3]); ssq = row16_sum(ssq);
            const float inv = 1.0f / fmaxf(sqrtf(ssq), 1e-12f);
            const f32x4 kk = kr * inv; const f32x4 ka = *(const f32x4*)(kaw + col);
            const f32x4 k = xk * (1.0f + (as - 1.0f) * ka);
            *(f32x4*)(R + off) = xr; *(f32x4*)(K + off) = k; *(f32x4*)(KK + off) = kk; *(f32x4*)(BV + off) = kk * as;
        }
    }
}


__device__ __forceinline__ void scan_load_chunk(const float* A0, const float* A1, const float* A2, const float* A3, const float* A4, const float* V, size_t base, int row0, int ch,
                                                LAS float* buf, LAS float* vbuf, int q) {
    constexpr int CH = 32;
    const int t0 = ch * CH;
    f32x4 tv[10]; float v0, v1;
#pragma unroll
    for (int i = 0; i < 10; ++i) { const int idx = q + 256 * i; const int arr = idx >> 9, rem = idx & 511, st = rem >> 4, c4 = rem & 15;
        const float* src = arr == 0 ? A0 : (arr == 1 ? A1 : (arr == 2 ? A2 : (arr == 3 ? A3 : A4))); tv[i] = *(const f32x4*)(src + base + (size_t)(t0 + st) * RW + c4 * 4); }
    v0 = V[base + (size_t)(t0 + (q >> 4)) * RW + row0 + (q & 15)];
    v1 = V[base + (size_t)(t0 + 16 + (q >> 4)) * RW + row0 + (q & 15)];
#pragma unroll
    for (int i = 0; i < 10; ++i) { const int idx = q + 256 * i; *(LAS f32x4*)(buf + idx * 4) = tv[i]; }
    vbuf[q] = v0; vbuf[256 + q] = v1;
}
__device__ __forceinline__ void attn_phase(const Ctx& C);
__device__ __forceinline__ void sgu_phase(const Ctx& C, int l);
__device__ __forceinline__ void scan_phase(const Ctx& C, int la, int ma, int lb, int mb, int mix_l) {
    CArgs* ap = get_args();
    unsigned char* ws = ap->ws;
    const float* ARR0 = (const float*)(ws + WS_R); const float* ARR1 = (const float*)(ws + WS_WDEC); const float* ARR2 = (const float*)(ws + WS_K);
    const float* ARR3 = (const float*)(ws + WS_KK); const float* ARR4 = (const float*)(ws + WS_BV); const float* V = (const float*)(ws + WS_VFIRST);
    float* YS = (float*)(ws + WS_YS);
    constexpr int CH = 32, NCH = TT / CH, BUF_F = 5 * CH * 64, VB_F = CH * 16;
    LAS float* buf = (LAS float*)C.lds;
    LAS float* vbuf = (LAS float*)C.lds + 2 * BUF_F;
    const bool split = C.G >= 256;
    const int nscan = split ? 128 : C.G;
    if (C.bx < nscan) {
        for (int task = C.bx; task < 128; task += nscan) {
            const int pair = task >> 2, b = pair >> 4, hd = pair & 15, row0 = (task & 3) * 16;
            const size_t base = (size_t)b * TT * RW + hd * 64;
            const int q = C.tid - 256;
            if (C.wave >= 4) scan_load_chunk(ARR0, ARR1, ARR2, ARR3, ARR4, V, base, row0, 0, buf, vbuf, q);
            __syncthreads();
            f32x4 S = (f32x4){0.f, 0.f, 0.f, 0.f};
            const int rr = (C.wave & 3) * 4 + (C.lane >> 4), cgp = C.lane & 15;
            for (int ch = 0; ch < NCH; ++ch) {
                const int bi = ch & 1;
                if (C.wave >= 4) { if (ch + 1 < NCH) scan_load_chunk(ARR0, ARR1, ARR2, ARR3, ARR4, V, base, row0, ch + 1, buf + (bi ^ 1) * BUF_F, vbuf + (bi ^ 1) * VB_F, q); }
                else {
                    const LAS float* bb = buf + bi * BUF_F + cgp * 4; const LAS float* vb = vbuf + bi * VB_F + rr;
                    float* yp = YS + base + (size_t)(ch * CH) * RW + row0 + rr;
                    float yacc = 0.f, ypend = 0.f;
#pragma unroll 16
                    for (int st = 0; st < CH; ++st) {
                        const f32x4 r4 = *(const LAS f32x4*)(bb + (0 * CH + st) * 64), w4 = *(const LAS f32x4*)(bb + (1 * CH + st) * 64), k4 = *(const LAS f32x4*)(bb + (2 * CH + st) * 64),
                                    kk4 = *(const LAS f32x4*)(bb + (3 * CH + st) * 64), b4 = *(const LAS f32x4*)(bb + (4 * CH + st) * 64);
                        const float vi = vb[st * 16];
                        float sa = (S[0] * kk4[0] + S[1] * kk4[1]) + (S[2] * kk4[2] + S[3] * kk4[3]);
                        const f32x4 T = S * w4 + k4 * vi;
                        float yr = ypend;
                        sa += dppf<0xB1>(sa); yr += dppf<0xB1>(yr);
                        sa += dppf<0x4E>(sa); yr += dppf<0x4E>(yr);
                        sa += dppf<0x141>(sa); yr += dppf<0x141>(yr);
                        sa += dppf<0x128>(sa); yr += dppf<0x128>(yr);
                        if (st > 0) { yacc = (cgp == ((st - 1) & 15)) ? yr : yacc;
                            if (((st - 1) & 15) == 15) yp[(size_t)(st - 16 + cgp) * RW] = yacc; }
                        S = T - b4 * sa;
                        ypend = (S[0] * r4[0] + S[1] * r4[1]) + (S[2] * r4[2] + S[3] * r4[3]);
                    }
                    { const float yr = row16_sum(ypend); yacc = (cgp == ((CH - 1) & 15)) ? yr : yacc; yp[(size_t)(CH - 16 + cgp) * RW] = yacc; }
                }
                __syncthreads();
            }
        }
        if (!split) { if (ma) convert_phase(C, la, ma); if (mb) convert_phase(C, lb, mb); if (mix_l >= 0) { __syncthreads(); attn_phase(C); sgu_phase(C, mix_l); } }
    } else {
        Ctx Cc = C; Cc.bx = C.bx - nscan; Cc.G = C.G - nscan; Cc.gw = Cc.bx * 8 + C.wave; Cc.NGW = Cc.G * 8;
        if (ma) convert_phase(Cc, la, ma);
        if (mb) convert_phase(Cc, lb, mb);
        if (mix_l >= 0) { __syncthreads(); attn_phase(Cc); sgu_phase(Cc, mix_l); }
    }
}

__device__ __forceinline__ void post_phase(const Ctx& C, int l) {
    CArgs* ap = get_args();
    unsigned char* ws = ap->ws;
    const float* R = (const float*)(ws + WS_R); const float* K = (const float*)(ws + WS_K); const float* V = (const float*)(ws + WS_VFIRST); const float* YS = (const float*)(ws + WS_YS);
    const bf16* Gb = (const bf16*)(ws + WS_G); bf16* YR = (bf16*)(ws + WS_YRWKV);
    const float* OA = (const float*)(ws + WS_OATT); const float* LSE = (const float*)(ws + WS_LSE); bf16* YA = (bf16*)(ws + WS_YATT);
    const float* rk = ap->in[I_RK] + (size_t)l * RW; const float* lw = ap->in[I_LNXW] + (size_t)l * RW; const float* lb = ap->in[I_LNXB] + (size_t)l * RW;
    for (int row = C.gw; row < MROWS; row += C.NGW) {
#pragma unroll
        for (int i = 0; i < 4; ++i) { const int col = i * 256 + C.lane * 4; const size_t off = (size_t)row * RW + col;
            const f32x4 y = *(const f32x4*)(YS + off), r = *(const f32x4*)(R + off), k = *(const f32x4*)(K + off), v = *(const f32x4*)(V + off);
            const float mean = row16_sum((y[0] + y[1]) + (y[2] + y[3])) * (1.0f / 64.0f);
            const f32x4 d = y - mean;
            const float var = row16_sum((d[0] * d[0] + d[1] * d[1]) + (d[2] * d[2] + d[3] * d[3])) * (1.0f / 64.0f);
            const float rstd = rsqrtf(var + 64e-5f);
            const f32x4 rkk = r * k * *(const f32x4*)(rk + col);
            const float bonus = row16_sum((rkk[0] + rkk[1]) + (rkk[2] + rkk[3]));
            const f32x4 g = ld_bf4(Gb + off);
            const f32x4 o = (d * rstd * *(const f32x4*)(lw + col) + *(const f32x4*)(lb + col) + v * bonus) * g;
            u32x2 w; w.x = cvt_pk_bf16(o[0], o[1]); w.y = cvt_pk_bf16(o[2], o[3]); *(u32x2*)(YR + off) = w;
        }
        { const int hs = C.lane >> 4, d0 = (C.lane & 15) * 8;
            const float l0 = LSE[(size_t)row * 12 + hs], l1 = LSE[(size_t)row * 12 + 4 + hs], l2 = LSE[(size_t)row * 12 + 8 + hs];
            const float mx = fmaxf(l0, fmaxf(l1, l2)); float w0 = __expf(l0 - mx), w1 = __expf(l1 - mx), w2 = __expf(l2 - mx); const float inv = 1.0f / (w0 + w1 + w2); w0 *= inv; w1 *= inv; w2 *= inv;
            const float* o0 = OA + ((size_t)row * 12 + hs) * 128 + d0; const float* o1 = o0 + 4 * 128; const float* o2 = o0 + 8 * 128;
            const f32x4 x0 = *(const f32x4*)o0 * w0 + *(const f32x4*)o1 * w1 + *(const f32x4*)o2 * w2;
            const f32x4 x1 = *(const f32x4*)(o0 + 4) * w0 + *(const f32x4*)(o1 + 4) * w1 + *(const f32x4*)(o2 + 4) * w2;
            u32x4 w; w.x = cvt_pk_bf16(x0[0], x0[1]); w.y = cvt_pk_bf16(x0[2], x0[3]); w.z = cvt_pk_bf16(x1[0], x1[1]); w.w = cvt_pk_bf16(x1[2], x1[3]);
            *(u32x4*)(YA + (size_t)row * 512 + hs * 128 + d0) = w; }
    }
}
#define MFMA16(a_, b_, c_) __builtin_amdgcn_mfma_f32_16x16x32_bf16((a_), (b_), (c_), 0, 0, 0)
__device__ __forceinline__ void attn_phase(const Ctx& C) {
    CArgs* ap = get_args();
    const bf16* proj = (const bf16*)(ap->ws + WS_PROJ); float* OA = (float*)(ap->ws + WS_OATT); float* LSE = (float*)(ap->ws + WS_LSE);
    constexpr int KST = 136, VST = 264, PST = 264;
    LAS bf16* sK = (LAS bf16*)C.lds;
    LAS bf16* sP = (LAS bf16*)(C.lds + 69632) + C.wave * 16 * PST;
    const int fr = C.lane & 15, fq = C.lane >> 4;
    const float scale = 0.08838834764831845f, NEG = -__builtin_inff();
    for (int unit = C.bx; unit < 768; unit += C.G) {
        const int b = unit / 384, rem = unit % 384, h = rem >> 5, sub = rem & 31;
        const int g = h >> 2, dil = g == 0 ? 1 : (g == 1 ? 4 : 16), nbk = 32 / dil, r = sub / nbk, n = sub % nbk;
        const float slope = h < 8 ? exp2f(-0.5f * (float)(h + 1)) : exp2f(-(float)(h - 3));
        const size_t rowbase = (size_t)b * TT;
        const int qcol = PC_QKV + h * 128, kcol = PC_QKV + 1536 + h * 128, vcol = PC_QKV + 3072 + h * 128;
#pragma unroll
        for (int i = 0; i < 8; ++i) { const int idx = C.tid + 512 * i, j = idx >> 4, c8 = idx & 15, sk = (n - 1) * 128 + j;
            u32x4 val = (u32x4){0u, 0u, 0u, 0u};
            if (sk >= 0) val = *(const u32x4*)(proj + (rowbase + (size_t)sk * dil + r) * NPROJ + kcol + c8 * 8);
            *(LAS u32x4*)(sK + j * KST + c8 * 8) = val; }
        const size_t qtok = rowbase + (size_t)(n * 128 + C.wave * 16 + fr) * dil + r;
        bf16x8 qf[4];
#pragma unroll
        for (int ks = 0; ks < 4; ++ks) qf[ks] = *(const bf16x8*)(proj + qtok * NPROJ + qcol + ks * 32 + fq * 8);
        __syncthreads();
        f32x4 sc[16];
#pragma unroll
        for (int nt = 0; nt < 16; ++nt) { f32x4 acc = (f32x4){0.f, 0.f, 0.f, 0.f};
#pragma unroll
            for (int ks = 0; ks < 4; ++ks) { const bf16x8 kf = *(const LAS bf16x8*)(sK + (nt * 16 + fr) * KST + ks * 32 + fq * 8); acc = MFMA16(qf[ks], kf, acc); }
            sc[nt] = acc; }
        float mx[4] = {NEG, NEG, NEG, NEG};
#pragma unroll
        for (int nt = 0; nt < 16; ++nt)
#pragma unroll
            for (int rg = 0; rg < 4; ++rg) { const int i = C.wave * 16 + fq * 4 + rg, j = nt * 16 + fr, rel = 128 + i - j;
                const bool valid = rel >= 0 && rel <= 128 && (n > 0 || j >= 128);
                float s = sc[nt][rg] * scale - slope * (float)(rel * dil); s = valid ? s : NEG; sc[nt][rg] = s; mx[rg] = fmaxf(mx[rg], s); }
        float sum[4];
#pragma unroll
        for (int rg = 0; rg < 4; ++rg) { mx[rg] = row16_max(mx[rg]); sum[rg] = 0.f; }
#pragma unroll
        for (int nt = 0; nt < 16; ++nt)
#pragma unroll
            for (int rg = 0; rg < 4; ++rg) { const float p = __expf(sc[nt][rg] - mx[rg]); sum[rg] += p; sP[(fq * 4 + rg) * PST + nt * 16 + fr] = f2bf1(p); }
#pragma unroll
        for (int rg = 0; rg < 4; ++rg) sum[rg] = row16_sum(sum[rg]);
        __syncthreads();
#pragma unroll
        for (int i = 0; i < 8; ++i) { const int idx = C.tid + 512 * i, j = idx >> 4, c8 = idx & 15, sk = (n - 1) * 128 + j;
            u32x4 val = (u32x4){0u, 0u, 0u, 0u};
            if (sk >= 0) val = *(const u32x4*)(proj + (rowbase + (size_t)sk * dil + r) * NPROJ + vcol + c8 * 8);
            LAS bf16* dst = sK + (c8 * 8) * VST + j;
            dst[0 * VST] = (bf16)(val.x & 0xffffu); dst[1 * VST] = (bf16)(val.x >> 16); dst[2 * VST] = (bf16)(val.y & 0xffffu); dst[3 * VST] = (bf16)(val.y >> 16);
            dst[4 * VST] = (bf16)(val.z & 0xffffu); dst[5 * VST] = (bf16)(val.z >> 16); dst[6 * VST] = (bf16)(val.w & 0xffffu); dst[7 * VST] = (bf16)(val.w >> 16); }
        __syncthreads();
        bf16x8 pf[8];
#pragma unroll
        for (int ks = 0; ks < 8; ++ks) pf[ks] = *(const LAS bf16x8*)(sP + fr * PST + ks * 32 + fq * 8);
        float inv[4];
#pragma unroll
        for (int rg = 0; rg < 4; ++rg) inv[rg] = 1.0f / sum[rg];
#pragma unroll
        for (int nd = 0; nd < 8; ++nd) { f32x4 acc = (f32x4){0.f, 0.f, 0.f, 0.f};
#pragma unroll
            for (int ks = 0; ks < 8; ++ks) { const bf16x8 vf = *(const LAS bf16x8*)(sK + (nd * 16 + fr) * VST + ks * 32 + fq * 8); acc = MFMA16(pf[ks], vf, acc); }
#pragma unroll
            for (int rg = 0; rg < 4; ++rg) { const size_t tok = rowbase + (size_t)(n * 128 + C.wave * 16 + fq * 4 + rg) * dil + r;
                OA[(tok * 12 + h) * 128 + nd * 16 + fr] = acc[rg] * inv[rg]; } }
        if (fr == 0) {
#pragma unroll
            for (int rg = 0; rg < 4; ++rg) { const size_t tok = rowbase + (size_t)(n * 128 + C.wave * 16 + fq * 4 + rg) * dil + r; LSE[tok * 12 + h] = mx[rg] + __logf(sum[rg]); } }
        __syncthreads();
    }
}

__device__ __forceinline__ void sgu_phase(const Ctx& C, int l) {
    CArgs* ap = get_args();
    const bf16* proj = (const bf16*)(ap->ws + WS_PROJ); bf16* YS_ = (bf16*)(ap->ws + WS_YSGU);
    const float* lng = ap->in[I_SLNG] + (size_t)l * 512; const float* lnb = ap->in[I_SLNB] + (size_t)l * 512;
    const float* wsrc = ap->in[I_SWS] + (size_t)l * 4 * 128 * 128; const float* bsrc = ap->in[I_SB] + (size_t)l * 4 * 128;
    constexpr int ST = 136;
    LAS bf16* sV = (LAS bf16*)C.lds; LAS bf16* sW = (LAS bf16*)(C.lds + 34816); LAS float* stat = (LAS float*)(C.lds + 69632);
    const int fr = C.lane & 15, fq = C.lane >> 4;
    for (int unit = C.bx; unit < 256; unit += C.G) {
        const int g = unit & 3; const size_t t0 = (size_t)(unit >> 2) * 128;
        for (int i = 0; i < 16; ++i) { const int tok = C.wave * 16 + i;
            const u32x4 raw = *(const u32x4*)(proj + (t0 + tok) * NPROJ + PC_SGU + 512 + C.lane * 8);
            const float x0 = bflo(raw.x), x1 = bfhi(raw.x), x2 = bflo(raw.y), x3 = bfhi(raw.y), x4 = bflo(raw.z), x5 = bfhi(raw.z), x6 = bflo(raw.w), x7 = bfhi(raw.w);
            float s = ((x0 + x1) + (x2 + x3)) + ((x4 + x5) + (x6 + x7)); float q = ((x0 * x0 + x1 * x1) + (x2 * x2 + x3 * x3)) + ((x4 * x4 + x5 * x5) + (x6 * x6 + x7 * x7));
            s = wave_sum(s); q = wave_sum(q); const float mean = s * (1.0f / 512.0f); const float var = fmaxf(q * (1.0f / 512.0f) - mean * mean, 0.f);
            if (C.lane == 0) { stat[tok * 2] = mean; stat[tok * 2 + 1] = rsqrtf(var + 1e-5f); } }
        __syncthreads();
#pragma unroll
        for (int i = 0; i < 4; ++i) { const int idx = C.tid + 512 * i, s = idx >> 4, c8 = idx & 15;
            const u32x4 raw = *(const u32x4*)(proj + (t0 + s) * NPROJ + PC_SGU + 512 + g * 128 + c8 * 8);
            const float mean = stat[s * 2], rstd = stat[s * 2 + 1];
            float x[8] = {bflo(raw.x), bfhi(raw.x), bflo(raw.y), bfhi(raw.y), bflo(raw.z), bfhi(raw.z), bflo(raw.w), bfhi(raw.w)};
#pragma unroll
            for (int e = 0; e < 8; ++e) { const int d = c8 * 8 + e; sV[d * ST + s] = f2bf1((x[e] - mean) * rstd * lng[g * 128 + d] + lnb[g * 128 + d]); } }
#pragma unroll
        for (int i = 0; i < 8; ++i) { const int idx = C.tid + 512 * i, t = idx >> 5, s4 = idx & 31;
            f32x4 w = *(const f32x4*)(wsrc + ((size_t)g * 128 + t) * 128 + s4 * 4);
#pragma unroll
            for (int e = 0; e < 4; ++e) if (s4 * 4 + e > t) w[e] = 0.f;
            u32x2 o; o.x = cvt_pk_bf16(w[0], w[1]); o.y = cvt_pk_bf16(w[2], w[3]); *(LAS u32x2*)(sW + t * ST + s4 * 4) = o; }
        __syncthreads();
        bf16x8 wf[4];
#pragma unroll
        for (int ks = 0; ks < 4; ++ks) wf[ks] = *(const LAS bf16x8*)(sW + (C.wave * 16 + fr) * ST + ks * 32 + fq * 8);
#pragma unroll
        for (int nd = 0; nd < 8; ++nd) { f32x4 acc = (f32x4){0.f, 0.f, 0.f, 0.f};
#pragma unroll
            for (int ks = 0; ks < 4; ++ks) { const bf16x8 vf = *(const LAS bf16x8*)(sV + (nd * 16 + fr) * ST + ks * 32 + fq * 8); acc = MFMA16(wf[ks], vf, acc); }
#pragma unroll
            for (int rg = 0; rg < 4; ++rg) { const int t = C.wave * 16 + fq * 4 + rg, d = nd * 16 + fr;
                const float mixed = acc[rg] + bsrc[g * 128 + t]; const float u = bf2f(proj[(t0 + t) * NPROJ + PC_SGU + g * 128 + d]);
                YS_[(t0 + t) * 512 + g * 128 + d] = f2bf1(u * mixed); } }
        __syncthreads();
    }
}


__device__ __forceinline__ void lora_phase(const Ctx& C, int l) {
    CArgs* ap = get_args(); unsigned char* ws = ap->ws;
    const bf16* A = (const bf16*)(ws + WS_ALORA); const bf16* Wl = (const bf16*)(ws + WS_WLORA);
    const int fr = C.lane & 15, fq = C.lane >> 4;
    const int nblk = l == 0 ? 3 : 4, nitems = 512 * nblk * 8;
    for (int it = C.gw; it < nitems; it += C.NGW) {
        const int cg = it & 7, rb = (it >> 3) & 511, blk = it >> 12;
        const int k0 = blk == 0 ? 0 : (blk == 1 ? 64 : (blk == 2 ? 128 : 288)), nk = blk == 2 ? 5 : (blk == 3 ? 1 : 2);
        f32x4 acc[8];
#pragma unroll
        for (int j = 0; j < 8; ++j) acc[j] = (f32x4){0.f, 0.f, 0.f, 0.f};
        const bf16* ap0 = A + (size_t)(rb * 16 + fr) * KLORA + k0 + fq * 8;
        const bf16* bp0 = Wl + (size_t)(blk * 1024 + cg * 128 + fr) * KLORA + k0 + fq * 8;
        for (int ks = 0; ks < nk; ++ks) {
            const bf16x8 af = *(const bf16x8*)(ap0 + ks * 32);
#pragma unroll
            for (int j = 0; j < 8; ++j) { const bf16x8 bf = *(const bf16x8*)(bp0 + (size_t)j * 16 * KLORA + ks * 32); acc[j] = MFMA16(bf, af, acc[j]); }
        }
        const float* bias = blk == 0 ? ap->in[I_DW0] + (size_t)l * RW : (blk == 1 ? ap->in[I_A0] + (size_t)l * RW : ap->in[I_VV0]);
        float* dstf = (float*)(ws + (blk == 0 ? WS_WDEC : (blk == 1 ? WS_ASIG : WS_VG))); bf16* dstb = (bf16*)(ws + WS_G);
        const size_t roff = (size_t)(rb * 16 + fr) * RW;
#pragma unroll
        for (int j = 0; j < 8; ++j) { const int col = cg * 128 + j * 16 + fq * 4; f32x4 v = acc[j];
            if (blk == 2) { u32x2 w; w.x = cvt_pk_bf16(v[0], v[1]); w.y = cvt_pk_bf16(v[2], v[3]); *(u32x2*)(dstb + roff + col) = w; }
            else { v = v + *(const f32x4*)(bias + col);
                if (blk == 0) {
#pragma unroll
                    for (int e = 0; e < 4; ++e) { const float z = -v[e]; const float sp = fmaxf(z, 0.f) + __logf(1.0f + __expf(-fabsf(z))); v[e] = __expf(-__expf(-sp - 0.5f)); } }
                else {
#pragma unroll
                    for (int e = 0; e < 4; ++e) v[e] = sigmoidf_(v[e]); }
                *(f32x4*)(dstf + roff + col) = v; } }
    }
}

template <class Epi> __device__ __forceinline__ void run_gemm(const Ctx& C, const bf16* A, const bf16* Bt, int M, int N, int K, const Epi& E) {
#ifdef ZERO_LDS
    for (int i = C.tid; i < 131072 / 16; i += 512) *(LAS u32x4*)(C.lds + i * 16) = (u32x4){0u, 0u, 0u, 0u};
    __syncthreads();
#endif
    pg8::Gemm g{A, Bt, M, N, K}; pg8::StaticOrder S; S.init(M, N, C.G, (int)C.bx);
    pg8::gemm_phase<Epi, pg8::StaticOrder, GEMM_ALIGN, GEMM_SP2>(C.lds, g, S, E, C.tid);
}

__device__ __forceinline__ Ctx make_ctx(unsigned char* lds_raw, int wave0) {
    Ctx C; int ln; asm volatile("v_mbcnt_lo_u32_b32 %0, -1, 0\n\tv_mbcnt_hi_u32_b32 %0, -1, %0" : "=v"(ln)); int t = wave0 * 64 + ln; int bx = blockIdx.x; asm volatile("" : "+s"(bx));
    C.lds = (LAS unsigned char*)lds_raw; C.tid = t; C.lane = t & 63; C.wave = __builtin_amdgcn_readfirstlane(t >> 6);
    C.G = gridDim.x; C.bx = bx; C.gw = bx * 8 + C.wave; C.NGW = C.G * 8; return C;
}

#define XB_TMO      128
#define XB_XCNT(j)  (256  + 64 * (j))
#define XB_XSUB(j)  (1280 + 64 * (j))
#define XB_XGEN(j)  (2304 + 64 * (j))
#define XB_TOP      3328
#define XB_TOPGEN   3392
#define XCD_BAR_WORDS 3456
#define XB_SPIN_CAP (1u << 18)

__device__ __forceinline__ unsigned xb_ld(unsigned* p)              { return __hip_atomic_load(p, __ATOMIC_RELAXED, __HIP_MEMORY_SCOPE_AGENT); }
__device__ __forceinline__ unsigned xb_add(unsigned* p, unsigned v) { return __hip_atomic_fetch_add(p, v, __ATOMIC_RELAXED, __HIP_MEMORY_SCOPE_AGENT); }
__device__ __forceinline__ unsigned xb_xcc_id() { return (unsigned)__builtin_amdgcn_s_getreg((3 << 11) | 20) & 0xFu; }
#define XB_SPIN(cond, bar) do { unsigned _sp = 0; while (cond) { __builtin_amdgcn_s_sleep(1); \
    if ((++_sp & 255u) == 0u) { if (xb_ld(&(bar)[XB_TMO])) break; if (_sp > XB_SPIN_CAP) { atomicAdd(&(bar)[XB_TMO], 1u); break; } } } } while (0)

struct XcdBarrier {
    unsigned* bar; unsigned x;
    volatile LAS unsigned* st;
};

__device__ __forceinline__ XcdBarrier xcd_barrier_post(unsigned* bar, volatile LAS unsigned* st) {
    XcdBarrier b; b.bar = bar; b.x = xb_xcc_id(); b.st = st;
    if (threadIdx.x == 0) (void)xb_add(&bar[XB_XCNT(b.x)], 1u);
    return b;
}
__device__ __forceinline__ void xcd_barrier_complete(unsigned* bar, unsigned x, unsigned& nloc, unsigned& nx) {
    const unsigned G = gridDim.x * gridDim.y * gridDim.z;
    unsigned sum, cnt, mine, sp = 0u;
    for (;;) {
        sum = 0u; cnt = 0u; mine = 0u;
#pragma unroll
        for (unsigned j = 0; j < 16; ++j) { const unsigned c = xb_ld(&bar[XB_XCNT(j)]); sum += c; cnt += (c > 0u) ? 1u : 0u; mine = (j == x) ? c : mine; }
        if (sum == G) break;
        __builtin_amdgcn_s_sleep(1);
        if ((++sp & 255u) == 0u) { if (xb_ld(&bar[XB_TMO])) break; if (sp > XB_SPIN_CAP) { atomicAdd(&bar[XB_TMO], 1u); break; } }
    }
    nloc = mine > 0u ? mine : 1u; nx = cnt > 0u ? cnt : 1u;
}

__device__ __forceinline__ void xcd_barrier(const XcdBarrier& b) {
    asm volatile("s_waitcnt vmcnt(0)" ::: "memory");
    __syncthreads();
    if (threadIdx.x == 0) {
        unsigned* bar = b.bar;
        __builtin_amdgcn_s_waitcnt(0);
        unsigned nloc = b.st[0], nx = b.st[1];
        if (nloc == 0u) { xcd_barrier_complete(bar, b.x, nloc, nx); b.st[0] = nloc; b.st[1] = nx; }
        const unsigned old = xb_add(&bar[XB_XSUB(b.x)], 1u);
        const unsigned gen = old / nloc;
        if (old + 1u == (gen + 1u) * nloc) {
            __builtin_amdgcn_fence(__ATOMIC_RELEASE, "agent");
            asm volatile("s_waitcnt vmcnt(0)" ::: "memory");
            const unsigned og = xb_add(&bar[XB_TOP], 1u);
            const unsigned tg = og / nx;
            if (og + 1u == (tg + 1u) * nx) xb_add(&bar[XB_TOPGEN], 1u);
            else XB_SPIN(xb_ld(&bar[XB_TOPGEN]) == tg, bar);
            __builtin_amdgcn_fence(__ATOMIC_ACQUIRE, "agent");
            xb_add(&bar[XB_XGEN(b.x)], 1u);
            asm volatile("s_waitcnt vmcnt(0)" ::: "memory");
        } else {
            XB_SPIN(xb_ld(&bar[XB_XGEN(b.x)]) == gen, bar);
            __builtin_amdgcn_fence(__ATOMIC_ACQUIRE, "agent");
            asm volatile("s_waitcnt vmcnt(0)" ::: "memory");
        }
    }
    __syncthreads();
}

#define XB_WS_WORD 1024
#define XB_LDS_OFF 147392
__device__ __forceinline__ void xcd_sync(unsigned char* lds_raw) {
    XcdBarrier b; b.bar = (unsigned*)get_args()->ws + XB_WS_WORD; b.x = xb_xcc_id(); b.st = (volatile LAS unsigned*)(lds_raw + XB_LDS_OFF);
    xcd_barrier(b);
}
__device__ __forceinline__ void grid_barrier(unsigned* bar, unsigned target) {
    asm volatile("s_waitcnt vmcnt(0) lgkmcnt(0)" ::: "memory");
    __syncthreads();
    if (threadIdx.x == 0) {
        __builtin_amdgcn_fence(__ATOMIC_RELEASE, "agent");
        asm volatile("s_waitcnt vmcnt(0)" ::: "memory");
        __hip_atomic_fetch_add(bar, 1u, __ATOMIC_RELAXED, __HIP_MEMORY_SCOPE_AGENT);
        while (__hip_atomic_load(bar, __ATOMIC_RELAXED, __HIP_MEMORY_SCOPE_AGENT) < target) __builtin_amdgcn_s_sleep(2);
#ifdef BAR_DELAY
        { const unsigned long long t0 = __builtin_amdgcn_s_memrealtime(); while (__builtin_amdgcn_s_memrealtime() - t0 < 5000ull) __builtin_amdgcn_s_sleep(8); }
#endif
        __builtin_amdgcn_fence(__ATOMIC_ACQUIRE, "agent");
        asm volatile("s_waitcnt vmcnt(0)" ::: "memory");
    }
    __syncthreads();
}

#ifdef STOPK
__device__ __forceinline__ void dump_u32(float* out, const unsigned char* srcb, size_t nwords, bool first) {
    const unsigned* src = (const unsigned*)srcb;
    for (size_t i = (size_t)blockIdx.x * 512 + threadIdx.x; i < (size_t)MROWS * DM; i += (size_t)gridDim.x * 512) {
        const unsigned w = src[i % nwords]; const unsigned hh = (w ^ (w >> 15)) * 2654435761u; const float v = (float)((hh ^ (hh >> 13)) * 2246822519u >> 8) * (1.0f / 16777216.0f);
        out[i] = first ? v : out[i] + v; }
}
#ifndef STOPL
#define STOPL 1
#endif
#define STOP_AT(k, ...) if (l == STOPL && STOPK == (k)) { CArgs* ap = get_args(); unsigned char* ws = ap->ws; float* out = ap->out; __VA_ARGS__; return; }
#else
#define STOP_AT(k, ...)
#endif

#ifdef STOPK
__device__ __forceinline__ void sum_region(const unsigned char* srcb, size_t ld, size_t w0, size_t nw, size_t nrows, unsigned* acc) {
    const unsigned* src = (const unsigned*)srcb; unsigned part = 0u;
    for (size_t i = (size_t)blockIdx.x * 512 + threadIdx.x; i < nw * nrows; i += (size_t)gridDim.x * 512) {
        const size_t r = i / nw, c = i % nw; const unsigned w = src[r * ld + w0 + c]; const unsigned hh = (w ^ (w >> 15)) * 2654435761u + (unsigned)i * 40503u; part += (hh ^ (hh >> 13)) * 2246822519u; }
    atomicAdd(acc, part);
}
__device__ __forceinline__ void bcast_sum(float* out, unsigned* acc, unsigned target) {
    grid_barrier(acc - 64, target);
    const unsigned tot = __hip_atomic_load(acc, __ATOMIC_RELAXED, __HIP_MEMORY_SCOPE_AGENT);
    for (size_t i = (size_t)blockIdx.x * 512 + threadIdx.x; i < (size_t)MROWS * DM; i += (size_t)gridDim.x * 512) {
        const unsigned hh = (tot + (unsigned)i) * 2654435761u; out[i] = (float)((hh ^ (hh >> 13)) * 2246822519u >> 8) * (1.0f / 16777216.0f); }
}
#define ANYBIT(k, ...) if (l == STOPL && STOPK == (k)) { CArgs* ap = get_args(); unsigned char* ws = ap->ws; unsigned* acc = (unsigned*)ws + 64; __VA_ARGS__; bcast_sum(ap->out, acc, (unsigned)(++bar_idx) * gridDim.x); return; }
#else
#define ANYBIT(k, ...)
#endif
#define PH_BEGIN if (pidx >= ph_lo && pidx < ph_hi) { CArgs* ap = get_args(); unsigned char* ws = ap->ws; (void)ws; const Ctx C = make_ctx(lds_raw, wave0);
#define PH_END } if (pidx >= ph_lo && pidx + 1 < ph_hi) xcd_sync(lds_raw); ++pidx;
#define WSB(off) ((bf16*)(ws + (off)))
#define WSF(off) ((float*)(ws + (off)))
template <int l> __device__ __forceinline__ void layer_body(unsigned char* lds_raw, const int wave0, int& bar_idx, int& pidx, const int ph_lo, const int ph_hi) {
        PH_BEGIN run_gemm(C, WSB(WS_XN), WSB(WS_WGU1), MROWS, 2 * FF, DM, EpiSwiglu{WSB(WS_ACT)});
                 if (l == 0) {
                     const int nb = ((MROWS / 256) * (2 * FF / 256)) % C.G;
                     if (nb == 0) convert_phase(C, 0, 8);
                     else if (C.bx >= nb) { Ctx Cc = C; Cc.bx = C.bx - nb; Cc.G = C.G - nb; Cc.gw = Cc.bx * 8 + C.wave; Cc.NGW = Cc.G * 8; convert_phase(Cc, 0, 8); }
                 } PH_END
        STOP_AT(1, dump_u32(out, ws + WS_ACT, (size_t)MROWS * FF / 2, true))
        ANYBIT(101, sum_region(ws + WS_ACT, FF / 2, 0, FF / 2, MROWS, acc))
        PH_BEGIN run_gemm(C, WSB(WS_ACT), WSB(WS_WD1), MROWS, DM, FF, EpiProj{WSB(WS_YF), DM}); PH_END
        STOP_AT(2, dump_u32(out, ws + WS_YF, (size_t)MROWS * DM, true))
        ANYBIT(102, sum_region(ws + WS_YF, DM, 0, DM, MROWS, acc))
        PH_BEGIN if (l == 0) norm_phase<false, true>(C, WSB(WS_YF), ap->in[I_F1POST] + (size_t)l * DM, 0.5f, ap->in[I_X], WSB(824 * MiB), ap->in[I_MIXPRE] + (size_t)l * DM, WSB(WS_XN));
                 else norm_phase<true, true>(C, WSB(WS_YF), ap->in[I_F1POST] + (size_t)l * DM, 0.5f, WSB(824 * MiB), WSB(824 * MiB), ap->in[I_MIXPRE] + (size_t)l * DM, WSB(WS_XN)); PH_END
        STOP_AT(3, dump_u32(out, ws + WS_XN, (size_t)MROWS * DM / 2, true))
        ANYBIT(103, sum_region(ws + WS_XN, DM / 2, 0, DM / 2, MROWS, acc); sum_region((const unsigned char*)ap->out, DM, 0, DM, MROWS, acc))
#ifdef STOP_L1_P3
        if (l == 1) return;
#endif
        PH_BEGIN run_gemm(C, WSB(WS_XN), WSB(WS_WIN), MROWS, NPROJ, DM, EpiProj{WSB(WS_PROJ), NPROJ});
                 if (l == 0) { const int nb = ((MROWS / 256) * (NPROJ / 256)) % C.G;
                     if (nb == 0) convert_phase(C, 0, 16);
                     else if (C.bx >= nb) { Ctx Cc = C; Cc.bx = C.bx - nb; Cc.G = C.G - nb; Cc.gw = Cc.bx * 8 + C.wave; Cc.NGW = Cc.G * 8; convert_phase(Cc, 0, 16); } } PH_END
        STOP_AT(4, dump_u32(out, ws + WS_PROJ, (size_t)MROWS * NPROJ / 2, true))
        ANYBIT(104, sum_region(ws + WS_PROJ, NPROJ / 2, 1536, 160, MROWS, acc))
        ANYBIT(105, sum_region(ws + WS_PROJ, NPROJ / 2, 0, NPROJ / 2, MROWS, acc))
        STOP_AT(41, dump_u32(out, ws + WS_PROJ + 64 * MiB, (size_t)44 * MiB, true); dump_u32(out, ws + WS_PROJ + 176 * MiB, (size_t)16 * MiB, false))
        STOP_AT(42, dump_u32(out, ws + WS_PROJ + 128 * MiB, (size_t)28 * MiB, true))
        STOP_AT(43, dump_u32(out, ws + WS_PROJ + 176 * MiB, (size_t)16 * MiB, true))
#ifdef ONLY_LORAA
        PH_BEGIN loraA_phase(C, l); PH_END
#else
        PH_BEGIN loraA_phase(C, l); PH_END
#endif
        STOP_AT(5, dump_u32(out, ws + WS_ALORA, (size_t)MROWS * KLORA / 2, true))
        ANYBIT(106, sum_region(ws + WS_ALORA, KLORA / 2, 0, KLORA / 2, MROWS, acc))
        ANYBIT(107, sum_region(ws + WS_OATT, 1536, 0, 1536, MROWS, acc); sum_region(ws + WS_LSE, 12, 0, 12, MROWS, acc); sum_region(ws + WS_YSGU, 256, 0, 256, MROWS, acc))
#ifdef SKIP_LORA0
        PH_BEGIN if (l == 1) lora_phase(C, l); PH_END
#else
        PH_BEGIN lora_phase(C, l); PH_END
#endif
        ANYBIT(108, sum_region(ws + WS_WDEC, RW, 0, RW, MROWS, acc); sum_region(ws + WS_ASIG, RW, 0, RW, MROWS, acc); sum_region(ws + WS_G, RW / 2, 0, RW / 2, MROWS, acc); if (l > 0) sum_region(ws + WS_VG, RW, 0, RW, MROWS, acc))
        STOP_AT(6, dump_u32(out, ws + 824 * MiB, (size_t)MROWS * RW / 2, true))
        STOP_AT(62, dump_u32(out, ws + WS_G, (size_t)MROWS * RW / 2, true))
        STOP_AT(61, dump_u32(out, ws + WS_WDEC, (size_t)MROWS * RW, true); dump_u32(out, ws + WS_ASIG, (size_t)MROWS * RW, false); dump_u32(out, ws + WS_VG, (size_t)MROWS * RW, false))
        PH_BEGIN prep_phase(C, l); PH_END
        ANYBIT(109, sum_region(ws + WS_R, RW, 0, RW, MROWS, acc); sum_region(ws + WS_K, RW, 0, RW, MROWS, acc); sum_region(ws + WS_KK, RW, 0, RW, MROWS, acc); sum_region(ws + WS_BV, RW, 0, RW, MROWS, acc); sum_region(ws + WS_VFIRST, RW, 0, RW, MROWS, acc))
        STOP_AT(7, dump_u32(out, ws + WS_R, (size_t)MROWS * RW, true); dump_u32(out, ws + WS_K, (size_t)MROWS * RW, false); dump_u32(out, ws + WS_KK, (size_t)MROWS * RW, false); dump_u32(out, ws + WS_BV, (size_t)MROWS * RW, false); dump_u32(out, ws + WS_VFIRST, (size_t)MROWS * RW, false))
        PH_BEGIN scan_phase(C, l, l == 0 ? 2 : 18, 1, l == 0 ? 12 : 0, l); PH_END
        ANYBIT(110, sum_region(ws + WS_YS, RW, 0, RW, MROWS, acc))
        STOP_AT(8, dump_u32(out, ws + WS_YS, (size_t)MROWS * RW, true))
        PH_BEGIN post_phase(C, l); PH_END
        ANYBIT(111, sum_region(ws + WS_YRWKV, RW / 2, 0, RW / 2, MROWS, acc); sum_region(ws + WS_YATT, 256, 0, 256, MROWS, acc))
        STOP_AT(9, dump_u32(out, ws + WS_YRWKV, (size_t)MROWS * RW / 2, true); dump_u32(out, ws + WS_YATT, (size_t)MROWS * 512 / 2, false))
        if (pidx >= ph_lo && pidx < ph_hi) { { CArgs* ap = get_args(); unsigned char* ws = ap->ws; const Ctx C = make_ctx(lds_raw, wave0); run_gemm(C, WSB(WS_YRWKV), WSB(WS_WBR_R), MROWS, DM, RW, EpiMerge<0>{WSB(WS_MERGED_F32), WSB(WS_MERGED_BF), WSB(WS_PROJ) + PC_GATE}); }
          { CArgs* ap = get_args(); unsigned char* ws = ap->ws; const Ctx C = make_ctx(lds_raw, wave0); run_gemm(C, WSB(WS_YATT), WSB(WS_WBR_A), MROWS, DM, 512, EpiMerge<1>{WSB(WS_MERGED_F32), WSB(WS_MERGED_BF), WSB(WS_PROJ) + PC_GATE + 2048}); }
          { CArgs* ap = get_args(); unsigned char* ws = ap->ws; const Ctx C = make_ctx(lds_raw, wave0); run_gemm(C, WSB(WS_YSGU), WSB(WS_WBR_S), MROWS, DM, 512, EpiMerge<2>{WSB(WS_MERGED_F32), WSB(WS_MERGED_BF), WSB(WS_PROJ) + PC_GATE + 4096}); } }
        if (pidx >= ph_lo && pidx + 1 < ph_hi) xcd_sync(lds_raw); ++pidx;
        ANYBIT(112, sum_region(ws + WS_MERGED_BF, DM / 2, 0, DM / 2, MROWS, acc))
        PH_BEGIN run_gemm(C, WSB(WS_MERGED_BF), WSB(WS_WOUT), MROWS, DM, DM, EpiProj{WSB(WS_Y), DM}); PH_END
        STOP_AT(11, dump_u32(out, ws + WS_Y, (size_t)MROWS * DM, true))
        ANYBIT(113, sum_region(ws + WS_Y, DM, 0, DM, MROWS, acc))
        PH_BEGIN norm_phase<true, true>(C, WSB(WS_Y), ap->in[I_MIXPOST] + (size_t)l * DM, 1.0f, WSB(824 * MiB), WSB(824 * MiB), ap->in[I_F2PRE] + (size_t)l * DM, WSB(WS_XN)); PH_END
        ANYBIT(114, sum_region(ws + WS_XN, DM / 2, 0, DM / 2, MROWS, acc); sum_region((const unsigned char*)ap->out, DM, 0, DM, MROWS, acc))
#ifdef STOP_L1_P12
        if (l == 1) return;
#endif
        PH_BEGIN run_gemm(C, WSB(WS_XN), WSB(WS_WGU2), MROWS, 2 * FF, DM, EpiSwiglu{WSB(WS_ACT)});
                 if (l == 0) { const int nb = ((MROWS / 256) * (2 * FF / 256)) % C.G;
                     if (nb == 0) convert_phase(C, 1, 1);
                     else if (C.bx >= nb) { Ctx Cc = C; Cc.bx = C.bx - nb; Cc.G = C.G - nb; Cc.gw = Cc.bx * 8 + C.wave; Cc.NGW = Cc.G * 8; convert_phase(Cc, 1, 1); } } PH_END
        PH_BEGIN run_gemm(C, WSB(WS_ACT), WSB(WS_WD2), MROWS, DM, FF, EpiProj{WSB(WS_YF), DM}); PH_END
        PH_BEGIN if (l == 0) norm_phase<true, true>(C, WSB(WS_YF), ap->in[I_F2POST] + (size_t)l * DM, 0.5f, WSB(824 * MiB), WSB(824 * MiB), ap->in[I_F1PRE] + DM, WSB(WS_XN));
                 else norm_phase<true, false>(C, WSB(WS_YF), ap->in[I_F2POST] + (size_t)l * DM, 0.5f, WSB(824 * MiB), ap->out, (const float*)nullptr, WSB(WS_XN)); PH_END
}

__global__ void __launch_bounds__(512, 2) mega(Args a_) {
    extern __shared__ __attribute__((aligned(16))) unsigned char lds_raw[];
    cg::grid_group grid = cg::this_grid();
    const int wave0 = __builtin_amdgcn_readfirstlane((int)threadIdx.x >> 6);
    int bar_idx = 0, pidx = 0; const int ph_lo = a_.ph_lo, ph_hi = a_.ph_hi;
    grid.sync();
    if (threadIdx.x < 16) ((LAS unsigned*)(lds_raw + XB_LDS_OFF))[threadIdx.x] = 0u;
    __syncthreads();
    (void)xcd_barrier_post((unsigned*)get_args()->ws + XB_WS_WORD, (volatile LAS unsigned*)(lds_raw + XB_LDS_OFF));
    PH_BEGIN convert_phase(C, 0, 5); prenorm_phase(C, ap->in[I_X], ap->in[I_F1PRE], WSB(WS_XN)); PH_END
#if defined(STOPK) && STOPK == 100
    { CArgs* ap = get_args(); unsigned char* ws = ap->ws; unsigned* acc = (unsigned*)ws + 64; sum_region(ws + WS_XN, DM / 2, 0, DM / 2, MROWS, acc); sum_region(ws + MiB, 1, 0, 1, (size_t)208 * MiB / 4, acc); bcast_sum(ap->out, acc, (unsigned)(++bar_idx) * gridDim.x); return; }
#endif
#if defined(STOPK) && STOPK == 0
    { CArgs* ap = get_args(); dump_u32(ap->out, ap->ws + WS_XN, (size_t)MROWS * DM / 2, true); return; }
#endif
#if defined(STOPK) && STOPK == 51
    { CArgs* ap = get_args(); dump_u32(ap->out, ap->ws + WS_WGU1, (size_t)2 * FF * DM / 2, true); return; }
#endif
#if defined(STOPK) && STOPK == 50
    { CArgs* ap = get_args(); dump_u32(ap->out, (const unsigned char*)ap->in[I_X], (size_t)MROWS * DM, true); return; }
#endif
    layer_body<0>(lds_raw, wave0, bar_idx, pidx, ph_lo, ph_hi);
#if !defined(STOP_L0) && !(defined(STOPK) && defined(STOPL) && STOPL == 0)
    layer_body<1>(lds_raw, wave0, bar_idx, pidx, ph_lo, ph_hi);
#endif
#ifdef DUMP_INPUTS
    { grid_barrier((unsigned*)get_args()->ws, (unsigned)(++bar_idx) * gridDim.x); CArgs* ap = get_args();
      dump_u32(ap->out, (const unsigned char*)ap->in[I_SHMU], 6720, true); dump_u32(ap->out, (const unsigned char*)ap->in[I_VMU], 32, false); dump_u32(ap->out, (const unsigned char*)ap->in[I_VV0], 1024, false); dump_u32(ap->out, (const unsigned char*)ap->in[I_VW2], 32768, false); }
#endif
}

extern "C" void kernel_launch(void* const* d_in, const int* in_sizes, int n_in, void* d_out, int out_size, void* d_ws, size_t ws_size, hipStream_t stream) {
    static int grid = 0;
    if (!grid) {
        int dev = 0, cus = 0, per_cu = 0;
        (void)hipGetDevice(&dev);
        (void)hipDeviceGetAttribute(&cus, hipDeviceAttributeMultiprocessorCount, dev);
        (void)hipFuncSetAttribute((const void*)mega, hipFuncAttributeMaxDynamicSharedMemorySize, LDS_BYTES);
        (void)hipOccupancyMaxActiveBlocksPerMultiprocessor(&per_cu, (const void*)mega, 512, LDS_BYTES);
        if (per_cu < 1) per_cu = 1;
        grid = cus * per_cu;
        if (n_in != N_INPUTS || out_size != MROWS * DM || ws_size < (size_t)856 * MiB) { fprintf(stderr, "kernel_launch: unexpected sizes n_in %d out %d ws %zu\n", n_in, out_size, ws_size); grid = -1; }
    }
    if (grid < 0) return;
    Args a{};
    for (int i = 0; i < N_INPUTS; ++i) a.in[i] = (const float*)d_in[i];
    a.out = (float*)d_out; a.ws = (unsigned char*)d_ws;
#ifndef N_PHASES_PER_LAUNCH
#define N_PHASES_PER_LAUNCH 64
#endif
    constexpr int TOTAL_PH = 31;
    for (int lo = 0; lo < TOTAL_PH; lo += N_PHASES_PER_LAUNCH) {
        (void)hipMemsetAsync(d_ws, 0, 32768, stream);
        a.ph_lo = lo; a.ph_hi = lo + N_PHASES_PER_LAUNCH < TOTAL_PH ? lo + N_PHASES_PER_LAUNCH : TOTAL_PH;
        void* args[] = {&a};
        hipError_t e = hipLaunchCooperativeKernel((void*)mega, dim3(grid), dim3(512), args, LDS_BYTES, stream);
        if (e != hipSuccess) { fprintf(stderr, "cooperative launch failed: %s (grid %d)\n", hipGetErrorString(e), grid); break; }
    }
}
```

```cpp
#define GEMM_ALIGN true
#define GEMM_SP2 true
#include <hip/hip_runtime.h>
#include <hip/hip_cooperative_groups.h>
#include <cstdio>
#include <cstdint>
namespace cg = cooperative_groups;
namespace pg8 {
#define PG8_LAS __attribute__((address_space(3)))
typedef unsigned short bf16_t;
typedef short bf16x8 __attribute__((ext_vector_type(8)));
typedef float f32x4 __attribute__((ext_vector_type(4)));
typedef unsigned u32x4 __attribute__((ext_vector_type(4)));
constexpr int BM = 256, BK = 64, HALF = 128, HTB = HALF * BK * 2  , STAGE_BYTES = 8 * HTB, NXCD = 8, WGM = 8;

__host__ __device__ __forceinline__ int lds_byte(int r, int c) { const int st = (r >> 4) * 2 + (c >> 5), rr = r & 15, cc = c & 31, ob = rr * 64 + cc * 2; return st * 1024 + (ob ^ (((ob >> 9) & 1) << 5)); }
__host__ __device__ __forceinline__ void stage_rc(int b, int& R, int& C) { const int st = b / 1024, sb = b % 1024, swz = sb ^ (((sb >> 9) & 1) << 5); R = (st >> 1) * 16 + swz / 64; C = (st & 1) * 32 + (swz % 64) / 2; }
__host__ __device__ __forceinline__ int perm32(int rho) { const int n = rho >> 4, i = rho & 15; return 8 * (i >> 2) + 4 * n + (i & 3); }

struct Unit { int pm, pn; };
struct Gemm { const bf16_t* A; const bf16_t* Bt; int M, N, K; };

struct StaticOrder {
    int nM, nN, nwg, G, c;
    __host__ __device__ void init(int M, int N, int G_, int c_) { nM = M / BM; nN = N / BM; nwg = nM * nN; G = G_; c = c_; }
    __host__ __device__ bool next(int i, Unit& u) const {
        const long L = (long)i * G + c; if (L >= nwg) return false;
        int wgid = (int)L; { const int q = nwg / NXCD, r = nwg % NXCD, xcd = wgid % NXCD, off = wgid / NXCD; wgid = (xcd < r ? xcd * (q + 1) : r * (q + 1) + (xcd - r) * q) + off; }
        const int nig = WGM * nN, gid = wgid / nig, fm = gid * WGM, gsz = (nM - fm) < WGM ? (nM - fm) : WGM;
        u.pm = fm + ((wgid % nig) % gsz); u.pn = (wgid % nig) / gsz; return true;
    }
    __device__ __forceinline__ void a_ready(const Unit&) const {}
    __device__ __forceinline__ void done(const Unit&) const {}
};
__device__ __forceinline__ unsigned cvt_pk_bf16(float lo, float hi) { unsigned r; asm volatile("v_cvt_pk_bf16_f32 %0, %1, %2" : "=v"(r) : "v"(lo), "v"(hi)); return r; }
typedef float f32x2 __attribute__((ext_vector_type(2)));
template <class Epi, class Sched, bool ALIGN_EPI = false, bool SP2 = false>
__device__ __forceinline__ void gemm_phase(PG8_LAS unsigned char* lds, const Gemm g, const Sched& S, const Epi& E, int tid_in) {
    int tid_ = tid_in; asm volatile("" : "+v"(tid_));
    const int tid = tid_, wid = __builtin_amdgcn_readfirstlane(tid >> 6), lane = tid & 63, wr = wid >> 2, wc = wid & 3, fr = lane & 15, fq = lane >> 4;
    const int K = g.K, nt = K / BK;
    unsigned voffA[2], voffB[2];
#pragma unroll
    for (int i = 0; i < 2; ++i) { int R, C; stage_rc(tid * 16 + i * 8192, R, C); const int Rb = Epi::PERM ? ((R & ~31) + perm32(R & 31)) : R;
        voffA[i] = (unsigned)(R * K + C) * 2u; voffB[i] = (unsigned)(Rb * K + C) * 2u; }
    const size_t kstep = (size_t)(BK * 2);
    const size_t hstep = (size_t)HALF * K * 2;
    const size_t tstep = 2 * hstep;
    const unsigned ldsw = (unsigned)wid * 1024u;
    const int aoff = lds_byte(wr * 64 + fr, fq * 8), boff = lds_byte(wc * 32 + fr, fq * 8);
#define PG8_SA(b, h) (((b) * 2 + (h)) * HTB)
#define PG8_SB(b, h) ((4 + (b) * 2 + (h)) * HTB)
#define PG8_STAGE(bufoff, gbase, voff) do { _Pragma("unroll") for (int _i = 0; _i < 2; ++_i) \
        __builtin_amdgcn_global_load_lds((const unsigned*)((const char*)(gbase) + (voff)[_i]), (PG8_LAS unsigned*)(lds + (bufoff) + ldsw + _i * 8192), 16, 0, 0); } while (0)
#define PG8_LDA(dst, b, h) do { _Pragma("unroll") for (int m = 0; m < 4; ++m) _Pragma("unroll") for (int k = 0; k < 2; ++k) dst[m][k] = *(const PG8_LAS bf16x8*)(lds + PG8_SA(b, h) + aoff + m * 2048 + k * 1024); } while (0)
#define PG8_LDB(dst, b, h) do { _Pragma("unroll") for (int n = 0; n < 2; ++n) _Pragma("unroll") for (int k = 0; k < 2; ++k) dst[n][k] = *(const PG8_LAS bf16x8*)(lds + PG8_SB(b, h) + boff + n * 2048 + k * 1024); } while (0)
#define PG8_MMA(ai, bj, At, Bt) do { __builtin_amdgcn_s_setprio(1); _Pragma("unroll") for (int m = 0; m < 4; ++m) _Pragma("unroll") for (int n = 0; n < 2; ++n) _Pragma("unroll") for (int k = 0; k < 2; ++k) \
        acc[ai][bj][m][n] = __builtin_amdgcn_mfma_f32_16x16x32_bf16(Bt[n][k], At[m][k], acc[ai][bj][m][n], 0, 0, 0); __builtin_amdgcn_s_setprio(0); } while (0)
#ifdef DRAIN_ALL
#define PG8_WAIT_V(n) asm volatile("s_waitcnt vmcnt(0)" ::: "memory")
#else
#define PG8_WAIT_V(n) asm volatile("s_waitcnt vmcnt(" #n ")" ::: "memory")
#endif
#define PG8_WAIT_L(n) asm volatile("s_waitcnt lgkmcnt(" #n ")" ::: "memory")
#define PG8_BAR __builtin_amdgcn_s_barrier()
#define PG8_SCHED __builtin_amdgcn_sched_barrier(0)
    Unit cur, nxt; int ui = 0;
    if (!S.next(0, cur)) return;
    f32x4 acc[2][2][4][2];
#pragma unroll
    for (int a = 0; a < 2; ++a)
#pragma unroll
        for (int b = 0; b < 2; ++b)
#pragma unroll
            for (int m = 0; m < 4; ++m)
#pragma unroll
                for (int n = 0; n < 2; ++n) acc[a][b][m][n] = (f32x4){0.f, 0.f, 0.f, 0.f};
    bf16x8 At[4][2], B0[2][2], B1[2][2];
    const char* cA = (const char*)g.A + (size_t)cur.pm * tstep; const char* cB = (const char*)g.Bt + (size_t)cur.pn * tstep;
    S.a_ready(cur);
    if constexpr (SP2) {
        PG8_STAGE(PG8_SB(0, 0), cB, voffB); PG8_STAGE(PG8_SB(0, 1), cB + hstep, voffB); PG8_STAGE(PG8_SA(0, 0), cA, voffA); PG8_STAGE(PG8_SA(0, 1), cA + hstep, voffA);
        if (wr == 1) PG8_BAR;
        PG8_WAIT_V(2); PG8_BAR;
        PG8_STAGE(PG8_SB(1, 0), cB + kstep, voffB); PG8_STAGE(PG8_SA(1, 0), cA + kstep, voffA); PG8_STAGE(PG8_SB(1, 1), cB + hstep + kstep, voffB);
        PG8_WAIT_V(6); PG8_BAR;
    } else {
        PG8_STAGE(PG8_SB(0, 0), cB, voffB); PG8_STAGE(PG8_SA(0, 0), cA, voffA); PG8_STAGE(PG8_SB(0, 1), cB + hstep, voffB); PG8_STAGE(PG8_SA(0, 1), cA + hstep, voffA);
        if (wr == 1) PG8_BAR;
        PG8_WAIT_V(4); PG8_BAR;
        PG8_STAGE(PG8_SB(1, 0), cB + kstep, voffB); PG8_STAGE(PG8_SA(1, 0), cA + kstep, voffA); PG8_STAGE(PG8_SB(1, 1), cB + hstep + kstep, voffB);
        PG8_WAIT_V(6); PG8_BAR;
    }
    for (;;) {
        const bool has_next = S.next(ui + 1, nxt);
        const char* nA = has_next ? (const char*)g.A + (size_t)nxt.pm * tstep : cA; const char* nB = has_next ? (const char*)g.Bt + (size_t)nxt.pn * tstep : cB;
        for (int t = 0; t < nt; t += 2) {
            const bool last = (t == nt - 2);
            const char* a1 = cA + (size_t)(t + 1) * kstep;
            const char* a2 = last ? nA : cA + (size_t)(t + 2) * kstep; const char* b2 = last ? nB : cB + (size_t)(t + 2) * kstep;
            const char* a3 = a2 + kstep; const char* b3 = b2 + kstep;
            if (last && has_next) S.a_ready(nxt);
            if constexpr (SP2) {
            PG8_LDB(B0, 0, 0); PG8_LDB(B1, 0, 1); PG8_SCHED; PG8_LDA(At, 0, 0); PG8_STAGE(PG8_SA(1, 1), a1 + hstep, voffA);
            PG8_WAIT_V(8); PG8_WAIT_L(0); PG8_BAR; PG8_MMA(0, 0, At, B0); PG8_MMA(0, 1, At, B1); PG8_BAR; PG8_SCHED;
            PG8_LDA(At, 0, 1); PG8_STAGE(PG8_SB(0, 0), b2, voffB); PG8_STAGE(PG8_SB(0, 1), b2 + hstep, voffB); PG8_STAGE(PG8_SA(0, 0), a2, voffA);
            PG8_WAIT_V(8); PG8_WAIT_L(0); PG8_BAR; PG8_MMA(1, 0, At, B0); PG8_MMA(1, 1, At, B1); PG8_BAR; PG8_SCHED;
            PG8_LDB(B0, 1, 0); PG8_LDB(B1, 1, 1); PG8_SCHED; PG8_LDA(At, 1, 0); PG8_STAGE(PG8_SA(0, 1), a2 + hstep, voffA);
            PG8_WAIT_V(8); PG8_WAIT_L(0); PG8_BAR; PG8_MMA(0, 0, At, B0); PG8_MMA(0, 1, At, B1); PG8_BAR; PG8_SCHED;
            PG8_LDA(At, 1, 1); PG8_STAGE(PG8_SB(1, 0), b3, voffB); PG8_STAGE(PG8_SB(1, 1), b3 + hstep, voffB); PG8_STAGE(PG8_SA(1, 0), a3, voffA);
            PG8_WAIT_V(8); PG8_WAIT_L(0); PG8_BAR; PG8_MMA(1, 0, At, B0); PG8_MMA(1, 1, At, B1); PG8_BAR; PG8_SCHED;
            } else {
            PG8_LDB(B0, 0, 0); PG8_SCHED; PG8_LDA(At, 0, 0); PG8_STAGE(PG8_SA(1, 1), a1 + hstep, voffA);
            PG8_WAIT_L(8); PG8_BAR; PG8_WAIT_L(0); PG8_MMA(0, 0, At, B0); PG8_BAR; PG8_SCHED;
            PG8_LDB(B1, 0, 1); PG8_STAGE(PG8_SB(0, 0), b2, voffB);
            PG8_BAR; PG8_WAIT_L(0); PG8_MMA(0, 1, At, B1); PG8_BAR;
            PG8_LDA(At, 0, 1); PG8_STAGE(PG8_SA(0, 0), a2, voffA);
            PG8_BAR; PG8_WAIT_L(0); PG8_MMA(1, 0, At, B0); PG8_BAR; PG8_SCHED;
            PG8_STAGE(PG8_SB(0, 1), b2 + hstep, voffB);
            PG8_WAIT_V(6); PG8_BAR; PG8_MMA(1, 1, At, B1); PG8_BAR;
            PG8_LDB(B0, 1, 0); PG8_SCHED; PG8_LDA(At, 1, 0); PG8_STAGE(PG8_SA(0, 1), a2 + hstep, voffA);
            PG8_WAIT_L(8); PG8_BAR; PG8_WAIT_L(0); PG8_MMA(0, 0, At, B0); PG8_BAR; PG8_SCHED;
            PG8_LDB(B1, 1, 1); PG8_STAGE(PG8_SB(1, 0), b3, voffB);
            PG8_BAR; PG8_WAIT_L(0); PG8_MMA(0, 1, At, B1); PG8_BAR;
            PG8_LDA(At, 1, 1); PG8_STAGE(PG8_SA(1, 0), a3, voffA);
            PG8_BAR; PG8_WAIT_L(0); PG8_MMA(1, 0, At, B0); PG8_BAR; PG8_SCHED;
            PG8_STAGE(PG8_SB(1, 1), b3 + hstep, voffB);
            PG8_WAIT_V(6); PG8_BAR; PG8_MMA(1, 1, At, B1); PG8_BAR;
            }
        }
        if constexpr (ALIGN_EPI) { if (wr == 0) PG8_BAR; }
        if constexpr (!Epi::AFTER_DRAIN) { E(acc, cur, wr, wc, fr, fq); S.done(cur); }
        if (!has_next) break;
#pragma unroll
        for (int a = 0; a < 2; ++a)
#pragma unroll
            for (int b = 0; b < 2; ++b)
#pragma unroll
                for (int m = 0; m < 4; ++m)
#pragma unroll
                    for (int n = 0; n < 2; ++n) acc[a][b][m][n] = (f32x4){0.f, 0.f, 0.f, 0.f};
        cur = nxt; cA = nA; cB = nB; ++ui;
        if constexpr (ALIGN_EPI) { if (wr == 1) PG8_BAR; }
    }
    PG8_WAIT_V(0);
    if constexpr (!ALIGN_EPI) { if (wr == 0) PG8_BAR; }
    PG8_BAR;
    if constexpr (Epi::AFTER_DRAIN) { E.fused(acc, cur, wr, wc, fr, fq, lds, wid, lane); S.done(cur); }
#undef PG8_SA
#undef PG8_SB
#undef PG8_STAGE
#undef PG8_LDA
#undef PG8_LDB
#undef PG8_MMA
#undef PG8_WAIT_V
#undef PG8_WAIT_L
#undef PG8_BAR
#undef PG8_SCHED
}
}
#define LAS __attribute__((address_space(3)))
typedef unsigned short bf16;
typedef pg8::f32x4 f32x4;
typedef pg8::bf16x8 bf16x8;
typedef pg8::u32x4 u32x4;
typedef unsigned u32x2 __attribute__((ext_vector_type(2)));
using pg8::cvt_pk_bf16;

constexpr int TT = 4096, MROWS = 8192, DM = 2048, FF = 5504, RW = 1024;
constexpr int NPROJ = 15360, PC_PV = 3360, PC_QKV = 3584, PC_SGU = 8192, PC_GATE = 9216;
constexpr int KLORA = 384;
constexpr size_t MiB = 1u << 20;
constexpr size_t WS_WGU1 = 1 * MiB, WS_WD1 = 44 * MiB, WS_WIN = 65 * MiB + MiB / 2, WS_WBR_R = 125 * MiB + MiB / 2, WS_WBR_A = 129 * MiB + MiB / 2,
                 WS_WBR_S = 131 * MiB + MiB / 2, WS_WOUT = 133 * MiB + MiB / 2, WS_WGU2 = 141 * MiB + MiB / 2, WS_WD2 = 184 * MiB + MiB / 2, WS_WLORA = 206 * MiB,
                 WS_XN = 209 * MiB, WS_VFIRST = 241 * MiB, WS_U = 273 * MiB;
constexpr size_t WS_PROJ = WS_U, WS_ACT = WS_U, WS_YF = WS_U + 96 * MiB;
constexpr size_t WS_R = 513 * MiB, WS_K = 545 * MiB, WS_KK = 577 * MiB, WS_BV = 609 * MiB, WS_WDEC = 641 * MiB, WS_ASIG = 673 * MiB, WS_VG = 705 * MiB, WS_G = 737 * MiB,
                 WS_ALORA = 753 * MiB, WS_OATT = 759 * MiB, WS_LSE = 807 * MiB, WS_YSGU = 808 * MiB, WS_YATT = 816 * MiB, WS_END = 824 * MiB;
constexpr size_t WS_MERGED_F32 = WS_R, WS_MERGED_BF = WS_KK, WS_Y = WS_BV, WS_YS = WS_ASIG, WS_YRWKV = WS_VG;
constexpr int LDS_BYTES = 147456;

enum { I_X = 0, I_F1PRE, I_F1GU, I_F1DN, I_F1POST, I_MIXPRE, I_WIN, I_SHMU, I_DW0, I_DW2, I_A0, I_A2, I_G2, I_KK, I_KA, I_RK, I_LNXW, I_LNXB,
       I_VW1, I_VMU, I_VV0, I_VW2, I_SLNG, I_SLNB, I_SWS, I_SB, I_WBR, I_WBA, I_WBS, I_WOUT, I_MIXPOST, I_F2PRE, I_F2GU, I_F2DN, I_F2POST, N_INPUTS };
struct Args { const float* in[N_INPUTS]; float* out; unsigned char* ws; int ph_lo, ph_hi; };
typedef const __attribute__((address_space(4))) Args CArgs;
__device__ __forceinline__ CArgs* get_args() { CArgs* p = (CArgs*)__builtin_amdgcn_kernarg_segment_ptr(); asm volatile("" : "+s"(p)); return p; }

__device__ __forceinline__ float bf2f(unsigned v) { return __uint_as_float(v << 16); }
__device__ __forceinline__ float bflo(unsigned w) { return __uint_as_float(w << 16); }
__device__ __forceinline__ float bfhi(unsigned w) { return __uint_as_float(w & 0xffff0000u); }
__device__ __forceinline__ unsigned short f2bf1(float f) { return (unsigned short)(cvt_pk_bf16(f, 0.f) & 0xffffu); }
__device__ __forceinline__ float sigmoidf_(float x) { return __builtin_amdgcn_rcpf(1.0f + __expf(-x)); }
__device__ __forceinline__ float tanhf_(float x) { return 2.0f * sigmoidf_(2.0f * x) - 1.0f; }
__device__ __forceinline__ float siluf_(float x) { return x * sigmoidf_(x); }
__device__ __forceinline__ float gelutf_(float x) { const float u = 0.7978845608028654f * (x + 0.044715f * x * x * x); return x * sigmoidf_(2.0f * u); }
template <int CTRL> __device__ __forceinline__ float dppf(float x) { return __builtin_bit_cast(float, __builtin_amdgcn_mov_dpp(__builtin_bit_cast(int, x), CTRL, 0xf, 0xf, true)); }
__device__ __forceinline__ float row16_sum(float x) { x += dppf<0xB1>(x); x += dppf<0x4E>(x); x += dppf<0x141>(x); x += dppf<0x128>(x); return x; }
__device__ __forceinline__ float row16_max(float x) { x = fmaxf(x, dppf<0xB1>(x)); x = fmaxf(x, dppf<0x4E>(x)); x = fmaxf(x, dppf<0x141>(x)); x = fmaxf(x, dppf<0x128>(x)); return x; }
__device__ __forceinline__ float wave_sum(float v) {
    v = row16_sum(v);
    const int iv = __builtin_bit_cast(int, v);
    const float s0 = __builtin_bit_cast(float, __builtin_amdgcn_readlane(iv, 0)), s1 = __builtin_bit_cast(float, __builtin_amdgcn_readlane(iv, 16)),
                s2 = __builtin_bit_cast(float, __builtin_amdgcn_readlane(iv, 32)), s3 = __builtin_bit_cast(float, __builtin_amdgcn_readlane(iv, 48));
    return (s0 + s1) + (s2 + s3);
}
#define LDS_WAIT() asm volatile("s_waitcnt lgkmcnt(0)" ::: "memory")

using pg8::Unit; using pg8::BM; using pg8::HALF;
struct EpiSwiglu {
    static constexpr bool PERM = true, AFTER_DRAIN = false;
    bf16* O;
    __device__ __forceinline__ void operator()(const f32x4 (&acc)[2][2][4][2], const Unit& u, int wr, int wc, int fr, int fq) const {
        const int row0 = u.pm * BM + wr * 64 + fr, col0 = u.pn * 128 + wc * 32 + 8 * fq;
#pragma unroll
        for (int ai = 0; ai < 2; ++ai)
#pragma unroll
            for (int m = 0; m < 4; ++m) {
                bf16* rowp = O + (size_t)(row0 + ai * HALF + m * 16) * FF + col0;
                const f32x4 g0 = acc[ai][0][m][0], g1 = acc[ai][0][m][1], u0 = acc[ai][1][m][0], u1 = acc[ai][1][m][1];
                u32x4 w;
                w.x = cvt_pk_bf16(siluf_(g0[0]) * u0[0], siluf_(g0[1]) * u0[1]); w.y = cvt_pk_bf16(siluf_(g0[2]) * u0[2], siluf_(g0[3]) * u0[3]);
                w.z = cvt_pk_bf16(siluf_(g1[0]) * u1[0], siluf_(g1[1]) * u1[1]); w.w = cvt_pk_bf16(siluf_(g1[2]) * u1[2], siluf_(g1[3]) * u1[3]);
                *(u32x4*)rowp = w;
            }
    }
};
struct EpiF32 {
    static constexpr bool PERM = false, AFTER_DRAIN = false;
    float* C; int ldc;
    __device__ __forceinline__ void operator()(const f32x4 (&acc)[2][2][4][2], const Unit& u, int wr, int wc, int fr, int fq) const {
        const int row0 = u.pm * BM + wr * 64 + fr, col0 = u.pn * BM + wc * 32 + 4 * fq;
#pragma unroll
        for (int ai = 0; ai < 2; ++ai)
#pragma unroll
            for (int m = 0; m < 4; ++m) { float* rowp = C + (size_t)(row0 + ai * HALF + m * 16) * ldc + col0;
#pragma unroll
                for (int bj = 0; bj < 2; ++bj)
#pragma unroll
                    for (int n = 0; n < 2; ++n) *(f32x4*)(rowp + bj * HALF + n * 16) = acc[ai][bj][m][n]; }
    }
};
struct EpiProj {
    static constexpr bool PERM = true, AFTER_DRAIN = false;
    bf16* O; int ldc;
    __device__ __forceinline__ void operator()(const f32x4 (&acc)[2][2][4][2], const Unit& u, int wr, int wc, int fr, int fq) const {
        const int row0 = u.pm * BM + wr * 64 + fr, col0 = u.pn * BM + wc * 32 + 8 * fq;
        const int mode = u.pn < 32 ? 0 : (u.pn < 36 ? 1 : 2);
#pragma unroll
        for (int ai = 0; ai < 2; ++ai)
#pragma unroll
            for (int m = 0; m < 4; ++m) { bf16* rowp = O + (size_t)(row0 + ai * HALF + m * 16) * ldc + col0;
#pragma unroll
                for (int bj = 0; bj < 2; ++bj) { f32x4 v0 = acc[ai][bj][m][0], v1 = acc[ai][bj][m][1];
                    if (mode == 1) {
#pragma unroll
                        for (int j = 0; j < 4; ++j) { v0[j] = gelutf_(v0[j]); v1[j] = gelutf_(v1[j]); } }
                    else if (mode == 2) {
#pragma unroll
                        for (int j = 0; j < 4; ++j) { v0[j] = sigmoidf_(v0[j]); v1[j] = sigmoidf_(v1[j]); } }
                    u32x4 w; w.x = cvt_pk_bf16(v0[0], v0[1]); w.y = cvt_pk_bf16(v0[2], v0[3]); w.z = cvt_pk_bf16(v1[0], v1[1]); w.w = cvt_pk_bf16(v1[2], v1[3]);
                    *(u32x4*)(rowp + bj * HALF) = w; } }
    }
};
template <int MODE> __device__ __forceinline__ void lora_store(const f32x4 (&acc)[2][2][4][2], int row0, int col0, const float* bias, float* dstf, bf16* dstb) {
#pragma unroll
    for (int ai = 0; ai < 2; ++ai)
#pragma unroll
        for (int m = 0; m < 4; ++m) { const size_t roff = (size_t)(row0 + ai * HALF + m * 16) * RW;
#pragma unroll
            for (int bj = 0; bj < 2; ++bj)
#pragma unroll
                for (int n = 0; n < 2; ++n) { const int col = col0 + bj * HALF + n * 16; f32x4 v = acc[ai][bj][m][n];
                    if (MODE == 2) { u32x2 w; w.x = cvt_pk_bf16(v[0], v[1]); w.y = cvt_pk_bf16(v[2], v[3]); *(u32x2*)(dstb + roff + col) = w; }
                    else { v = v + *(const f32x4*)(bias + col);
                        if (MODE == 0) {
#pragma unroll
                            for (int j = 0; j < 4; ++j) { const float z = -v[j]; const float sp = fmaxf(z, 0.f) + __logf(1.0f + __expf(-fabsf(z))); v[j] = __expf(-__expf(-sp - 0.5f)); } }
                        else {
#pragma unroll
                            for (int j = 0; j < 4; ++j) v[j] = sigmoidf_(v[j]); }
                        *(f32x4*)(dstf + roff + col) = v; } }
            asm volatile("" ::: "memory"); }
}
struct EpiLora {
    static constexpr bool PERM = false, AFTER_DRAIN = false;
    int l;
    __device__ __forceinline__ void operator()(const f32x4 (&acc)[2][2][4][2], const Unit& u, int wr, int wc, int fr, int fq) const {
        CArgs* ap = get_args(); unsigned char* ws = ap->ws;
        const int row0 = u.pm * BM + wr * 64 + fr; const int blk = u.pn >> 2; const int col0 = (u.pn & 3) * BM + wc * 32 + 4 * fq;
        if (blk == 0) lora_store<0>(acc, row0, col0, ap->in[I_DW0] + (size_t)l * RW, (float*)(ws + WS_WDEC), nullptr);
        else if (blk == 1) lora_store<1>(acc, row0, col0, ap->in[I_A0] + (size_t)l * RW, (float*)(ws + WS_ASIG), nullptr);
        else if (blk == 2) lora_store<2>(acc, row0, col0, nullptr, nullptr, (bf16*)(ws + WS_G));
        else lora_store<1>(acc, row0, col0, ap->in[I_VV0], (float*)(ws + WS_VG), nullptr);
    }
};
template <int PASS> struct EpiMerge {
    static constexpr bool PERM = false, AFTER_DRAIN = false;
    bf16* Mp; bf16* Mb; const bf16* gate;
    __device__ __forceinline__ void operator()(const f32x4 (&acc)[2][2][4][2], const Unit& u, int wr, int wc, int fr, int fq) const {
        const int row0 = u.pm * BM + wr * 64 + fr, col0 = u.pn * BM + wc * 32 + 4 * fq;
#pragma unroll
        for (int ai = 0; ai < 2; ++ai)
#pragma unroll
            for (int m = 0; m < 4; ++m) { const int row = row0 + ai * HALF + m * 16;
#pragma unroll
                for (int bj = 0; bj < 2; ++bj)
#pragma unroll
                    for (int n = 0; n < 2; ++n) { const int col = col0 + bj * HALF + n * 16; const size_t off = (size_t)row * DM + col;
                        const u32x2 gw = *(const u32x2*)(gate + (size_t)row * NPROJ + col);
                        f32x4 g; g[0] = bflo(gw.x); g[1] = bfhi(gw.x); g[2] = bflo(gw.y); g[3] = bfhi(gw.y);
                        f32x4 v = acc[ai][bj][m][n] * g;
                        if (PASS > 0) { const u32x2 pw = *(const u32x2*)(Mp + off); f32x4 pv; pv[0] = bflo(pw.x); pv[1] = bfhi(pw.x); pv[2] = bflo(pw.y); pv[3] = bfhi(pw.y); v = v + pv; }
                        u32x2 w; w.x = cvt_pk_bf16(v[0], v[1]); w.y = cvt_pk_bf16(v[2], v[3]);
                        *(u32x2*)((PASS < 2 ? Mp : Mb) + off) = w; } }
    }
};
__device__ __forceinline__ f32x4 ld_bf4(const bf16* p) { const u32x2 w = *(const u32x2*)p; f32x4 r; r[0] = bflo(w.x); r[1] = bfhi(w.x); r[2] = bflo(w.y); r[3] = bfhi(w.y); return r; }
struct Ctx { LAS unsigned char* lds; int tid, lane, wave, G, bx, gw, NGW; };

__device__ __forceinline__ void tr_item(const float* src, int ldn, int sc0, int k0, bf16* dst, int Kd, int dr0, LAS float* scr, int lane, bool zero) {
    const int c = lane & 7;
    if (zero) {
#pragma unroll
        for (int j = 0; j < 4; ++j) { const int n = (lane >> 3) + 8 * j; *(u32x4*)(dst + (size_t)(dr0 + n) * Kd + k0 + 8 * c) = (u32x4){0u, 0u, 0u, 0u}; }
        return;
    }
    float tv[32];
#pragma unroll
    for (int i = 0; i < 32; ++i) { const int kk = 2 * i + (lane >> 5); tv[i] = src[(size_t)(k0 + kk) * ldn + sc0 + (lane & 31)]; }
#pragma unroll
    for (int i = 0; i < 32; ++i) { const int kk = 2 * i + (lane >> 5); scr[kk * 33 + (lane & 31)] = tv[i]; }
    LDS_WAIT(); asm volatile("" ::: "memory");
#pragma unroll
    for (int j = 0; j < 4; ++j) { const int n = (lane >> 3) + 8 * j; const LAS float* s = scr + (8 * c) * 33 + n;
        u32x4 o; o.x = cvt_pk_bf16(s[0 * 33], s[1 * 33]); o.y = cvt_pk_bf16(s[2 * 33], s[3 * 33]); o.z = cvt_pk_bf16(s[4 * 33], s[5 * 33]); o.w = cvt_pk_bf16(s[6 * 33], s[7 * 33]);
        *(u32x4*)(dst + (size_t)(dr0 + n) * Kd + k0 + 8 * c) = o; }
    LDS_WAIT(); asm volatile("" ::: "memory");
}
__device__ __forceinline__ void convert_phase(const Ctx& C, int l, int mask) {
    CArgs* ap = get_args();
    unsigned char* ws = ap->ws;
    LAS float* scr = (LAS float*)(C.lds + C.wave * 8704);
    constexpr int N_GU = (2 * FF / 32) * (DM / 64), N_DN = (DM / 32) * (FF / 64), N_IN = (NPROJ / 32) * (DM / 64), N_BR = (DM / 32) * (RW / 64), N_BA = (DM / 32) * (512 / 64), N_WO = (DM / 32) * (DM / 64);
    constexpr int TOTAL = 2 * N_GU + 2 * N_DN + N_IN + N_BR + 2 * N_BA + N_WO;
    for (int it = C.gw; it < TOTAL; it += C.NGW) {
        int r = it;
        if (r < 2 * N_GU) {
            const int which = r >= N_GU; if (which) r -= N_GU;
            if (!(mask & (which ? 16 : 1))) continue;
            const float* src = ap->in[which ? I_F2GU : I_F1GU] + (size_t)l * DM * 2 * FF; bf16* dst = (bf16*)(ws + (which ? WS_WGU2 : WS_WGU1));
            const int nblk = 2 * FF / 32, nb = r % nblk, kb = r / nblk, rho0 = 32 * nb; const int pn = rho0 >> 8, bj = (rho0 >> 7) & 1, i0 = rho0 & 127;
            tr_item(src, 2 * FF, bj * FF + 128 * pn + i0, 64 * kb, dst, DM, rho0, scr, C.lane, false); continue; }
        r -= 2 * N_GU;
        if (r < 2 * N_DN) {
            const int which = r >= N_DN; if (which) r -= N_DN;
            if (!(mask & (which ? 2 : 4))) continue;
            const float* src = ap->in[which ? I_F2DN : I_F1DN] + (size_t)l * FF * DM; bf16* dst = (bf16*)(ws + (which ? WS_WD2 : WS_WD1));
            const int nblk = DM / 32, nb = r % nblk, kb = r / nblk;
            tr_item(src, DM, 32 * nb, 64 * kb, dst, FF, 32 * nb, scr, C.lane, false); continue; }
        r -= 2 * N_DN;
        if (r < N_IN) {
            if (!(mask & 8)) continue;
            const int nblk = NPROJ / 32, nb = r % nblk, kb = r / nblk, rho0 = 32 * nb; bf16* dst = (bf16*)(ws + WS_WIN);
            if (rho0 < PC_PV) tr_item(ap->in[I_WIN] + (size_t)l * DM * 15136, 15136, rho0, 64 * kb, dst, DM, rho0, scr, C.lane, false);
            else if (rho0 == PC_PV) tr_item(ap->in[I_VW1], 32, 0, 64 * kb, dst, DM, rho0, scr, C.lane, l == 0);
            else if (rho0 < PC_QKV) tr_item(ap->in[I_WIN], 15136, 0, 64 * kb, dst, DM, rho0, scr, C.lane, true);
            else tr_item(ap->in[I_WIN] + (size_t)l * DM * 15136, 15136, rho0 - 224, 64 * kb, dst, DM, rho0, scr, C.lane, false);
            continue; }
        r -= N_IN;
        if (!(mask & 2)) continue;
        if (r < N_BR) { const int nblk = DM / 32, nb = r % nblk, kb = r / nblk;
            tr_item(ap->in[I_WBR] + (size_t)l * RW * DM, DM, 32 * nb, 64 * kb, (bf16*)(ws + WS_WBR_R), RW, 32 * nb, scr, C.lane, false); continue; }
        r -= N_BR;
        if (r < 2 * N_BA) { const int which = r >= N_BA; if (which) r -= N_BA; const int nblk = DM / 32, nb = r % nblk, kb = r / nblk;
            tr_item(ap->in[which ? I_WBS : I_WBA] + (size_t)l * 512 * DM, DM, 32 * nb, 64 * kb, (bf16*)(ws + (which ? WS_WBR_S : WS_WBR_A)), 512, 32 * nb, scr, C.lane, false); continue; }
        r -= 2 * N_BA;
        { const int nblk = DM / 32, nb = r % nblk, kb = r / nblk;
            tr_item(ap->in[I_WOUT] + (size_t)l * DM * DM, DM, 32 * nb, 64 * kb, (bf16*)(ws + WS_WOUT), DM, 32 * nb, scr, C.lane, false); }
    }
    bf16* wl = (bf16*)(ws + WS_WLORA);
    if (mask & 8) for (int idx = C.bx * 512 + C.tid; idx < 4096 * KLORA; idx += C.G * 512) {
        const int n = idx & 1023, rest = idx >> 10, k = rest % KLORA, blk = rest / KLORA;
        float v = 0.f;
        if (blk == 0) { if (k < 64) v = ap->in[I_DW2][(size_t)l * 64 * RW + (size_t)k * RW + n]; }
        else if (blk == 1) { if (k >= 64 && k < 128) v = ap->in[I_A2][(size_t)l * 64 * RW + (size_t)(k - 64) * RW + n]; }
        else if (blk == 2) { if (k >= 128 && k < 288) v = ap->in[I_G2][(size_t)l * 160 * RW + (size_t)(k - 128) * RW + n]; }
        else { if (l > 0 && k >= 288 && k < 320) v = ap->in[I_VW2][(size_t)(k - 288) * RW + n]; }
        wl[(size_t)(blk * 1024 + n) * KLORA + k] = f2bf1(v);
    }
}

__device__ __forceinline__ void prenorm_phase(const Ctx& C, const float* x, const float* g, bf16* xn) {
    for (int row = C.gw; row < MROWS; row += C.NGW) {
        const f32x4* xr = (const f32x4*)(x + (size_t)row * DM) + C.lane; f32x4 v[8]; float ss = 0.f;
#pragma unroll
        for (int j = 0; j < 8; ++j) { v[j] = xr[64 * j]; ss += (v[j][0] * v[j][0] + v[j][1] * v[j][1]) + (v[j][2] * v[j][2] + v[j][3] * v[j][3]); }
        const float rs = rsqrtf(wave_sum(ss) * (1.0f / DM) + 1e-6f);
        u32x2* o = (u32x2*)(xn + (size_t)row * DM) + C.lane;
#pragma unroll
        for (int j = 0; j < 8; ++j) { const f32x4 gg = ((const f32x4*)g)[C.lane + 64 * j]; u32x2 w; w.x = cvt_pk_bf16(v[j][0] * rs * gg[0], v[j][1] * rs * gg[1]); w.y = cvt_pk_bf16(v[j][2] * rs * gg[2], v[j][3] * rs * gg[3]); o[64 * j] = w; }
    }
}
template <bool HIN_BF, bool HOUT_BF>
__device__ __forceinline__ void norm_phase(const Ctx& C, const bf16* y, const float* post_g, float fac, const void* h_in, void* h_out, const float* pre_g, bf16* xn) {
    for (int row = C.gw; row < MROWS; row += C.NGW) {
        const bf16* yr = y + (size_t)row * DM + C.lane * 4;
        f32x4 v[8]; float ss = 0.f;
#pragma unroll
        for (int j = 0; j < 8; ++j) { v[j] = ld_bf4(yr + 256 * j); ss += (v[j][0] * v[j][0] + v[j][1] * v[j][1]) + (v[j][2] * v[j][2] + v[j][3] * v[j][3]); }
        const float rs = rsqrtf(wave_sum(ss) * (1.0f / DM) + 1e-6f) * fac;
        float s2 = 0.f;
#pragma unroll
        for (int j = 0; j < 8; ++j) { const f32x4 gg = ((const f32x4*)post_g)[C.lane + 64 * j];
            f32x4 hh;
            if (HIN_BF) hh = ld_bf4((const bf16*)h_in + (size_t)row * DM + C.lane * 4 + 256 * j); else hh = ((const f32x4*)((const float*)h_in + (size_t)row * DM))[C.lane + 64 * j];
            v[j] = hh + v[j] * rs * gg;
            if (HOUT_BF) { u32x2 w; w.x = cvt_pk_bf16(v[j][0], v[j][1]); w.y = cvt_pk_bf16(v[j][2], v[j][3]); *(u32x2*)((bf16*)h_out + (size_t)row * DM + C.lane * 4 + 256 * j) = w;
                v[j][0] = bflo(w.x); v[j][1] = bfhi(w.x); v[j][2] = bflo(w.y); v[j][3] = bfhi(w.y); }
            else ((f32x4*)((float*)h_out + (size_t)row * DM))[C.lane + 64 * j] = v[j];
            s2 += (v[j][0] * v[j][0] + v[j][1] * v[j][1]) + (v[j][2] * v[j][2] + v[j][3] * v[j][3]); }
        if (pre_g) {
            const float r2 = rsqrtf(wave_sum(s2) * (1.0f / DM) + 1e-6f);
            u32x2* o = (u32x2*)(xn + (size_t)row * DM) + C.lane;
#pragma unroll
            for (int j = 0; j < 8; ++j) { const f32x4 gg = ((const f32x4*)pre_g)[C.lane + 64 * j]; u32x2 w; w.x = cvt_pk_bf16(v[j][0] * r2 * gg[0], v[j][1] * r2 * gg[1]); w.y = cvt_pk_bf16(v[j][2] * r2 * gg[2], v[j][3] * r2 * gg[3]); o[64 * j] = w; }
        }
    }
}

__device__ __forceinline__ void loraA_phase(const Ctx& C, int l) {
    CArgs* ap = get_args();
    const bf16* proj = (const bf16*)(ap->ws + WS_PROJ); bf16* A = (bf16*)(ap->ws + WS_ALORA);
    const float* mu = ap->in[I_SHMU] + (size_t)l * 3360;
    for (int row = C.gw; row < MROWS; row += C.NGW) {
        const bool first = (row % TT) == 0;
        const bf16* p1 = proj + (size_t)row * NPROJ + 3072; const bf16* p0 = proj + (size_t)(first ? row : row - 1) * NPROJ + 3072;
        bf16* arow = A + (size_t)row * KLORA;
#pragma unroll
        for (int h = 0; h < 2; ++h) { const int g = C.lane + 64 * h;
            if (g < 96) { const int c = 4 * g; f32x4 val = (f32x4){0.f, 0.f, 0.f, 0.f};
                if (c < 320) {
                    const f32x4 p = ld_bf4(p1 + c); f32x4 pp = ld_bf4(p0 + c); if (first) pp = (f32x4){0.f, 0.f, 0.f, 0.f};
                    f32x4 m = (f32x4){0.f, 0.f, 0.f, 0.f};
                    if (c < 288) m = *(const f32x4*)(mu + 3072 + c); else if (l > 0) m = *(const f32x4*)(ap->in[I_VMU] + (c - 288));
                    const f32x4 sv = p + (pp - p) * m;
#pragma unroll
                    for (int e = 0; e < 4; ++e) val[e] = c < 64 ? tanhf_(sv[e]) : (c < 128 ? sv[e] : (c < 288 ? sigmoidf_(sv[e]) : (l > 0 ? sv[e] : 0.f)));
                }
                u32x2 w; w.x = cvt_pk_bf16(val[0], val[1]); w.y = cvt_pk_bf16(val[2], val[3]); *(u32x2*)(arow + c) = w; } }
    }
}

__device__ __forceinline__ void prep_phase(const Ctx& C, int l) {
    CArgs* ap = get_args();
    unsigned char* ws = ap->ws; const bf16* proj = (const bf16*)(ws + WS_PROJ);
    float* R = (float*)(ws + WS_R); float* K = (float*)(ws + WS_K); float* KK = (float*)(ws + WS_KK); float* BV = (float*)(ws + WS_BV); float* V = (float*)(ws + WS_VFIRST);
    const float* AS = (const float*)(ws + WS_ASIG); const float* VG = (const float*)(ws + WS_VG);
    const float* mu = ap->in[I_SHMU] + (size_t)l * 3360; const float* kkw = ap->in[I_KK] + (size_t)l * RW; const float* kaw = ap->in[I_KA] + (size_t)l * RW;
    for (int row = C.gw; row < MROWS; row += C.NGW) {
        const bool first = (row % TT) == 0; const bf16* p1 = proj + (size_t)row * NPROJ; const bf16* p0 = proj + (size_t)(first ? row : row - 1) * NPROJ;
#pragma unroll
        for (int i = 0; i < 4; ++i) { const int col = i * 256 + C.lane * 4; const size_t off = (size_t)row * RW + col;
            f32x4 xr = ld_bf4(p1 + col), xk = ld_bf4(p1 + 1024 + col), xv = ld_bf4(p1 + 2048 + col);
            f32x4 qr = ld_bf4(p0 + col), qk = ld_bf4(p0 + 1024 + col), qv = ld_bf4(p0 + 2048 + col);
            if (first) { qr = (f32x4){0.f, 0.f, 0.f, 0.f}; qk = qr; qv = qr; }
            xr = xr + (qr - xr) * *(const f32x4*)(mu + col); xk = xk + (qk - xk) * *(const f32x4*)(mu + 1024 + col); xv = xv + (qv - xv) * *(const f32x4*)(mu + 2048 + col);
            f32x4 v = xv;
            if (l > 0) { const f32x4 vf = *(const f32x4*)(V + off), vg = *(const f32x4*)(VG + off); v = xv + (vf - xv) * vg; }
            *(f32x4*)(V + off) = v;
            const f32x4 as = *(const f32x4*)(AS + off);
            const f32x4 kr = xk * *(const f32x4*)(kkw + col);
            float ssq = (kr[0] * kr[0] + kr[1] * kr[1]) + (kr[2] * kr[2] + kr[3] * kr[3]); ssq = row16_sum(ssq);
            const float inv = 1.0f / fmaxf(sqrtf(ssq), 1e-12f);
            const f32x4 kk = kr * inv; const f32x4 ka = *(const f32x4*)(kaw + col);
            const f32x4 k = xk * (1.0f + (as - 1.0f) * ka);
            *(f32x4*)(R + off) = xr; *(f32x4*)(K + off) = k; *(f32x4*)(KK + off) = kk; *(f32x4*)(BV + off) = kk * as;
        }
    }
}


__device__ __forceinline__ void scan_load_chunk(const float* A0, const float* A1, const float* A2, const float* A3, const float* A4, const float* V, size_t base, int row0, int ch,
                                                LAS float* buf, LAS float* vbuf, int q) {
    constexpr int CH = 32;
    const int t0 = ch * CH;
    f32x4 tv[10]; float v0, v1;
#pragma unroll
    for (int i = 0; i < 10; ++i) { const int idx = q + 256 * i; const int arr = idx >> 9, rem = idx & 511, st = rem >> 4, c4 = rem & 15;
        const float* src = arr == 0 ? A0 : (arr == 1 ? A1 : (arr == 2 ? A2 : (arr == 3 ? A3 : A4))); tv[i] = *(const f32x4*)(src + base + (size_t)(t0 + st) * RW + c4 * 4); }
    v0 = V[base + (size_t)(t0 + (q >> 4)) * RW + row0 + (q & 15)];
    v1 = V[base + (size_t)(t0 + 16 + (q >> 4)) * RW + row0 + (q & 15)];
#pragma unroll
    for (int i = 0; i < 10; ++i) { const int idx = q + 256 * i; *(LAS f32x4*)(buf + idx * 4) = tv[i]; }
    vbuf[q] = v0; vbuf[256 + q] = v1;
}
__device__ __forceinline__ void attn_phase(const Ctx& C);
__device__ __forceinline__ void sgu_phase(const Ctx& C, int l);
__device__ __forceinline__ void scan_phase(const Ctx& C, int la, int ma, int lb, int mb, int mix_l) {
    CArgs* ap = get_args();
    unsigned char* ws = ap->ws;
    const float* ARR0 = (const float*)(ws + WS_R); const float* ARR1 = (const float*)(ws + WS_WDEC); const float* ARR2 = (const float*)(ws + WS_K);
    const float* ARR3 = (const float*)(ws + WS_KK); const float* ARR4 = (const float*)(ws + WS_BV); const float* V = (const float*)(ws + WS_VFIRST);
    float* YS = (float*)(ws + WS_YS);
    constexpr int CH = 32, NCH = TT / CH, BUF_F = 5 * CH * 64, VB_F = CH * 16;
    LAS float* buf = (LAS float*)C.lds;
    LAS float* vbuf = (LAS float*)C.lds + 2 * BUF_F;
    const bool split = C.G >= 256;
    const int nscan = split ? 128 : C.G;
    if (C.bx < nscan) {
        for (int task = C.bx; task < 128; task += nscan) {
            const int pair = task >> 2, b = pair >> 4, hd = pair & 15, row0 = (task & 3) * 16;
            const size_t base = (size_t)b * TT * RW + hd * 64;
            const int q = C.tid - 256;
            if (C.wave >= 4) scan_load_chunk(ARR0, ARR1, ARR2, ARR3, ARR4, V, base, row0, 0, buf, vbuf, q);
            __syncthreads();
            f32x4 S = (f32x4){0.f, 0.f, 0.f, 0.f};
            const int rr = (C.wave & 3) * 4 + (C.lane >> 4), cgp = C.lane & 15;
            if (C.wave < 4) __builtin_amdgcn_s_setprio(3);
            for (int ch = 0; ch < NCH; ++ch) {
                const int bi = ch & 1;
                if (C.wave >= 4) { if (ch + 1 < NCH) scan_load_chunk(ARR0, ARR1, ARR2, ARR3, ARR4, V, base, row0, ch + 1, buf + (bi ^ 1) * BUF_F, vbuf + (bi ^ 1) * VB_F, q); }
                else {
                    const LAS float* bb = buf + bi * BUF_F + cgp * 4; const LAS float* vb = vbuf + bi * VB_F + rr;
                    float* yp = YS + base + (size_t)(ch * CH) * RW + row0 + rr;
                    float yacc = 0.f, ypend = 0.f;
#pragma unroll 16
                    for (int st = 0; st < CH; ++st) {
                        const f32x4 r4 = *(const LAS f32x4*)(bb + (0 * CH + st) * 64), w4 = *(const LAS f32x4*)(bb + (1 * CH + st) * 64), k4 = *(const LAS f32x4*)(bb + (2 * CH + st) * 64),
                                    kk4 = *(const LAS f32x4*)(bb + (3 * CH + st) * 64), b4 = *(const LAS f32x4*)(bb + (4 * CH + st) * 64);
                        const float vi = vb[st * 16];
                        float sa = (S[0] * kk4[0] + S[1] * kk4[1]) + (S[2] * kk4[2] + S[3] * kk4[3]);
                        float yr = ypend;
                        sa += dppf<0xB1>(sa); yr += dppf<0xB1>(yr);
                        sa += dppf<0x4E>(sa); yr += dppf<0x4E>(yr);
                        sa += dppf<0x141>(sa); yr += dppf<0x141>(yr);
                        sa += dppf<0x128>(sa); yr += dppf<0x128>(yr);
                        if (st > 0) { yacc = (cgp == ((st - 1) & 15)) ? yr : yacc;
                            if (((st - 1) & 15) == 15) yp[(size_t)(st - 16 + cgp) * RW] = yacc; }
                        sa = -sa;
                        S = S * w4 + (b4 * sa + k4 * vi);
                        ypend = (S[0] * r4[0] + S[1] * r4[1]) + (S[2] * r4[2] + S[3] * r4[3]);
                    }
                    { const float yr = row16_sum(ypend); yacc = (cgp == ((CH - 1) & 15)) ? yr : yacc; yp[(size_t)(CH - 16 + cgp) * RW] = yacc; }
                }
                __syncthreads();
            }
            __builtin_amdgcn_s_setprio(0);
        }
        if (!split) { if (ma) convert_phase(C, la, ma); if (mb) convert_phase(C, lb, mb); if (mix_l >= 0) { __syncthreads(); attn_phase(C); sgu_phase(C, mix_l); } }
    } else {
        Ctx Cc = C; Cc.bx = C.bx - nscan; Cc.G = C.G - nscan; Cc.gw = Cc.bx * 8 + C.wave; Cc.NGW = Cc.G * 8;
        if (ma) convert_phase(Cc, la, ma);
        if (mb) convert_phase(Cc, lb, mb);
        if (mix_l >= 0) { __syncthreads(); attn_phase(Cc); sgu_phase(Cc, mix_l); }
    }
}

__device__ __forceinline__ void post_phase(const Ctx& C, int l) {
    CArgs* ap = get_args();
    unsigned char* ws = ap->ws;
    const float* R = (const float*)(ws + WS_R); const float* K = (const float*)(ws + WS_K); const float* V = (const float*)(ws + WS_VFIRST); const float* YS = (const float*)(ws + WS_YS);
    const bf16* Gb = (const bf16*)(ws + WS_G); bf16* YR = (bf16*)(ws + WS_YRWKV);
    const float* OA = (const float*)(ws + WS_OATT); const float* LSE = (const float*)(ws + WS_LSE); bf16* YA = (bf16*)(ws + WS_YATT);
    const float* rk = ap->in[I_RK] + (size_t)l * RW; const float* lw = ap->in[I_LNXW] + (size_t)l * RW; const float* lb = ap->in[I_LNXB] + (size_t)l * RW;
    for (int row = C.gw; row < MROWS; row += C.NGW) {
#pragma unroll
        for (int i = 0; i < 4; ++i) { const int col = i * 256 + C.lane * 4; const size_t off = (size_t)row * RW + col;
            const f32x4 y = *(const f32x4*)(YS + off), r = *(const f32x4*)(R + off), k = *(const f32x4*)(K + off), v = *(const f32x4*)(V + off);
            const float mean = row16_sum((y[0] + y[1]) + (y[2] + y[3])) * (1.0f / 64.0f);
            const f32x4 d = y - mean;
            const float var = row16_sum((d[0] * d[0] + d[1] * d[1]) + (d[2] * d[2] + d[3] * d[3])) * (1.0f / 64.0f);
            const float rstd = rsqrtf(var + 64e-5f);
            const f32x4 rkk = r * k * *(const f32x4*)(rk + col);
            const float bonus = row16_sum((rkk[0] + rkk[1]) + (rkk[2] + rkk[3]));
            const f32x4 g = ld_bf4(Gb + off);
            const f32x4 o = (d * rstd * *(const f32x4*)(lw + col) + *(const f32x4*)(lb + col) + v * bonus) * g;
            u32x2 w; w.x = cvt_pk_bf16(o[0], o[1]); w.y = cvt_pk_bf16(o[2], o[3]); *(u32x2*)(YR + off) = w;
        }
        { const int hs = C.lane >> 4, d0 = (C.lane & 15) * 8;
            const float l0 = LSE[(size_t)row * 12 + hs], l1 = LSE[(size_t)row * 12 + 4 + hs], l2 = LSE[(size_t)row * 12 + 8 + hs];
            const float mx = fmaxf(l0, fmaxf(l1, l2)); float w0 = __expf(l0 - mx), w1 = __expf(l1 - mx), w2 = __expf(l2 - mx); const float inv = 1.0f / (w0 + w1 + w2); w0 *= inv; w1 *= inv; w2 *= inv;
            const float* o0 = OA + ((size_t)row * 12 + hs) * 128 + d0; const float* o1 = o0 + 4 * 128; const float* o2 = o0 + 8 * 128;
            const f32x4 x0 = *(const f32x4*)o0 * w0 + *(const f32x4*)o1 * w1 + *(const f32x4*)o2 * w2;
            const f32x4 x1 = *(const f32x4*)(o0 + 4) * w0 + *(const f32x4*)(o1 + 4) * w1 + *(const f32x4*)(o2 + 4) * w2;
            u32x4 w; w.x = cvt_pk_bf16(x0[0], x0[1]); w.y = cvt_pk_bf16(x0[2], x0[3]); w.z = cvt_pk_bf16(x1[0], x1[1]); w.w = cvt_pk_bf16(x1[2], x1[3]);
            *(u32x4*)(YA + (size_t)row * 512 + hs * 128 + d0) = w; }
    }
}
#define MFMA16(a_, b_, c_) __builtin_amdgcn_mfma_f32_16x16x32_bf16((a_), (b_), (c_), 0, 0, 0)
__device__ __forceinline__ void attn_phase(const Ctx& C) {
    CArgs* ap = get_args();
    const bf16* proj = (const bf16*)(ap->ws + WS_PROJ); float* OA = (float*)(ap->ws + WS_OATT); float* LSE = (float*)(ap->ws + WS_LSE);
    constexpr int KST = 136, VST = 264, PST = 264;
    LAS bf16* sK = (LAS bf16*)C.lds;
    LAS bf16* sP = (LAS bf16*)(C.lds + 69632) + C.wave * 16 * PST;
    const int fr = C.lane & 15, fq = C.lane >> 4;
    const float scale = 0.08838834764831845f, NEG = -__builtin_inff();
    for (int unit = C.bx; unit < 768; unit += C.G) {
        const int b = unit / 384, rem = unit % 384, h = rem >> 5, sub = rem & 31;
        const int g = h >> 2, dil = g == 0 ? 1 : (g == 1 ? 4 : 16), nbk = 32 / dil, r = sub / nbk, n = sub % nbk;
        const float slope = h < 8 ? exp2f(-0.5f * (float)(h + 1)) : exp2f(-(float)(h - 3));
        const size_t rowbase = (size_t)b * TT;
        const int qcol = PC_QKV + h * 128, kcol = PC_QKV + 1536 + h * 128, vcol = PC_QKV + 3072 + h * 128;
#pragma unroll
        for (int i = 0; i < 8; ++i) { const int idx = C.tid + 512 * i, j = idx >> 4, c8 = idx & 15, sk = (n - 1) * 128 + j;
            u32x4 val = (u32x4){0u, 0u, 0u, 0u};
            if (sk >= 0) val = *(const u32x4*)(proj + (rowbase + (size_t)sk * dil + r) * NPROJ + kcol + c8 * 8);
            *(LAS u32x4*)(sK + j * KST + c8 * 8) = val; }
        const size_t qtok = rowbase + (size_t)(n * 128 + C.wave * 16 + fr) * dil + r;
        bf16x8 qf[4];
#pragma unroll
        for (int ks = 0; ks < 4; ++ks) qf[ks] = *(const bf16x8*)(proj + qtok * NPROJ + qcol + ks * 32 + fq * 8);
        __syncthreads();
        f32x4 sc[16];
#pragma unroll
        for (int nt = 0; nt < 16; ++nt) { f32x4 acc = (f32x4){0.f, 0.f, 0.f, 0.f};
#pragma unroll
            for (int ks = 0; ks < 4; ++ks) { const bf16x8 kf = *(const LAS bf16x8*)(sK + (nt * 16 + fr) * KST + ks * 32 + fq * 8); acc = MFMA16(qf[ks], kf, acc); }
            sc[nt] = acc; }
        float mx[4] = {NEG, NEG, NEG, NEG};
#pragma unroll
        for (int nt = 0; nt < 16; ++nt)
#pragma unroll
            for (int rg = 0; rg < 4; ++rg) { const int i = C.wave * 16 + fq * 4 + rg, j = nt * 16 + fr, rel = 128 + i - j;
                const bool valid = rel >= 0 && rel <= 128 && (n > 0 || j >= 128);
                float s = sc[nt][rg] * scale - slope * (float)(rel * dil); s = valid ? s : NEG; sc[nt][rg] = s; mx[rg] = fmaxf(mx[rg], s); }
        float sum[4];
#pragma unroll
        for (int rg = 0; rg < 4; ++rg) { mx[rg] = row16_max(mx[rg]); sum[rg] = 0.f; }
#pragma unroll
        for (int nt = 0; nt < 16; ++nt)
#pragma unroll
            for (int rg = 0; rg < 4; ++rg) { const float p = __expf(sc[nt][rg] - mx[rg]); sum[rg] += p; sP[(fq * 4 + rg) * PST + nt * 16 + fr] = f2bf1(p); }
#pragma unroll
        for (int rg = 0; rg < 4; ++rg) sum[rg] = row16_sum(sum[rg]);
        __syncthreads();
#pragma unroll
        for (int i = 0; i < 8; ++i) { const int idx = C.tid + 512 * i, j = idx >> 4, c8 = idx & 15, sk = (n - 1) * 128 + j;
            u32x4 val = (u32x4){0u, 0u, 0u, 0u};
            if (sk >= 0) val = *(const u32x4*)(proj + (rowbase + (size_t)sk * dil + r) * NPROJ + vcol + c8 * 8);
            LAS bf16* dst = sK + (c8 * 8) * VST + j;
            dst[0 * VST] = (bf16)(val.x & 0xffffu); dst[1 * VST] = (bf16)(val.x >> 16); dst[2 * VST] = (bf16)(val.y & 0xffffu); dst[3 * VST] = (bf16)(val.y >> 16);
            dst[4 * VST] = (bf16)(val.z & 0xffffu); dst[5 * VST] = (bf16)(val.z >> 16); dst[6 * VST] = (bf16)(val.w & 0xffffu); dst[7 * VST] = (bf16)(val.w >> 16); }
        __syncthreads();
        bf16x8 pf[8];
#pragma unroll
        for (int ks = 0; ks < 8; ++ks) pf[ks] = *(const LAS bf16x8*)(sP + fr * PST + ks * 32 + fq * 8);
        float inv[4];
#pragma unroll
        for (int rg = 0; rg < 4; ++rg) inv[rg] = 1.0f / sum[rg];
#pragma unroll
        for (int nd = 0; nd < 8; ++nd) { f32x4 acc = (f32x4){0.f, 0.f, 0.f, 0.f};
#pragma unroll
            for (int ks = 0; ks < 8; ++ks) { const bf16x8 vf = *(const LAS bf16x8*)(sK + (nd * 16 + fr) * VST + ks * 32 + fq * 8); acc = MFMA16(pf[ks], vf, acc); }
#pragma unroll
            for (int rg = 0; rg < 4; ++rg) { const size_t tok = rowbase + (size_t)(n * 128 + C.wave * 16 + fq * 4 + rg) * dil + r;
                OA[(tok * 12 + h) * 128 + nd * 16 + fr] = acc[rg] * inv[rg]; } }
        if (fr == 0) {
#pragma unroll
            for (int rg = 0; rg < 4; ++rg) { const size_t tok = rowbase + (size_t)(n * 128 + C.wave * 16 + fq * 4 + rg) * dil + r; LSE[tok * 12 + h] = mx[rg] + __logf(sum[rg]); } }
        __syncthreads();
    }
}

__device__ __forceinline__ void sgu_phase(const Ctx& C, int l) {
    CArgs* ap = get_args();
    const bf16* proj = (const bf16*)(ap->ws + WS_PROJ); bf16* YS_ = (bf16*)(ap->ws + WS_YSGU);
    const float* lng = ap->in[I_SLNG] + (size_t)l * 512; const float* lnb = ap->in[I_SLNB] + (size_t)l * 512;
    const float* wsrc = ap->in[I_SWS] + (size_t)l * 4 * 128 * 128; const float* bsrc = ap->in[I_SB] + (size_t)l * 4 * 128;
    constexpr int ST = 136;
    LAS bf16* sV = (LAS bf16*)C.lds; LAS bf16* sW = (LAS bf16*)(C.lds + 34816); LAS float* stat = (LAS float*)(C.lds + 69632);
    const int fr = C.lane & 15, fq = C.lane >> 4;
    for (int unit = C.bx; unit < 256; unit += C.G) {
        const int g = unit & 3; const size_t t0 = (size_t)(unit >> 2) * 128;
        for (int i = 0; i < 16; ++i) { const int tok = C.wave * 16 + i;
            const u32x4 raw = *(const u32x4*)(proj + (t0 + tok) * NPROJ + PC_SGU + 512 + C.lane * 8);
            const float x0 = bflo(raw.x), x1 = bfhi(raw.x), x2 = bflo(raw.y), x3 = bfhi(raw.y), x4 = bflo(raw.z), x5 = bfhi(raw.z), x6 = bflo(raw.w), x7 = bfhi(raw.w);
            float s = ((x0 + x1) + (x2 + x3)) + ((x4 + x5) + (x6 + x7)); float q = ((x0 * x0 + x1 * x1) + (x2 * x2 + x3 * x3)) + ((x4 * x4 + x5 * x5) + (x6 * x6 + x7 * x7));
            s = wave_sum(s); q = wave_sum(q); const float mean = s * (1.0f / 512.0f); const float var = fmaxf(q * (1.0f / 512.0f) - mean * mean, 0.f);
            if (C.lane == 0) { stat[tok * 2] = mean; stat[tok * 2 + 1] = rsqrtf(var + 1e-5f); } }
        __syncthreads();
#pragma unroll
        for (int i = 0; i < 4; ++i) { const int idx = C.tid + 512 * i, s = idx >> 4, c8 = idx & 15;
            const u32x4 raw = *(const u32x4*)(proj + (t0 + s) * NPROJ + PC_SGU + 512 + g * 128 + c8 * 8);
            const float mean = stat[s * 2], rstd = stat[s * 2 + 1];
            float x[8] = {bflo(raw.x), bfhi(raw.x), bflo(raw.y), bfhi(raw.y), bflo(raw.z), bfhi(raw.z), bflo(raw.w), bfhi(raw.w)};
#pragma unroll
            for (int e = 0; e < 8; ++e) { const int d = c8 * 8 + e; sV[d * ST + s] = f2bf1((x[e] - mean) * rstd * lng[g * 128 + d] + lnb[g * 128 + d]); } }
#pragma unroll
        for (int i = 0; i < 8; ++i) { const int idx = C.tid + 512 * i, t = idx >> 5, s4 = idx & 31;
            f32x4 w = *(const f32x4*)(wsrc + ((size_t)g * 128 + t) * 128 + s4 * 4);
#pragma unroll
            for (int e = 0; e < 4; ++e) if (s4 * 4 + e > t) w[e] = 0.f;
            u32x2 o; o.x = cvt_pk_bf16(w[0], w[1]); o.y = cvt_pk_bf16(w[2], w[3]); *(LAS u32x2*)(sW + t * ST + s4 * 4) = o; }
        __syncthreads();
        bf16x8 wf[4];
#pragma unroll
        for (int ks = 0; ks < 4; ++ks) wf[ks] = *(const LAS bf16x8*)(sW + (C.wave * 16 + fr) * ST + ks * 32 + fq * 8);
#pragma unroll
        for (int nd = 0; nd < 8; ++nd) { f32x4 acc = (f32x4){0.f, 0.f, 0.f, 0.f};
#pragma unroll
            for (int ks = 0; ks < 4; ++ks) { const bf16x8 vf = *(const LAS bf16x8*)(sV + (nd * 16 + fr) * ST + ks * 32 + fq * 8); acc = MFMA16(wf[ks], vf, acc); }
#pragma unroll
            for (int rg = 0; rg < 4; ++rg) { const int t = C.wave * 16 + fq * 4 + rg, d = nd * 16 + fr;
                const float mixed = acc[rg] + bsrc[g * 128 + t]; const float u = bf2f(proj[(t0 + t) * NPROJ + PC_SGU + g * 128 + d]);
                YS_[(t0 + t) * 512 + g * 128 + d] = f2bf1(u * mixed); } }
        __syncthreads();
    }
}


__device__ __forceinline__ void lora_phase(const Ctx& C, int l) {
    CArgs* ap = get_args(); unsigned char* ws = ap->ws;
    const bf16* A = (const bf16*)(ws + WS_ALORA); const bf16* Wl = (const bf16*)(ws + WS_WLORA);
    const int fr = C.lane & 15, fq = C.lane >> 4;
    const int nblk = l == 0 ? 3 : 4, nitems = 512 * nblk * 8;
    for (int it = C.gw; it < nitems; it += C.NGW) {
        const int cg = it & 7, rb = (it >> 3) & 511, blk = it >> 12;
        const int k0 = blk == 0 ? 0 : (blk == 1 ? 64 : (blk == 2 ? 128 : 288)), nk = blk == 2 ? 5 : (blk == 3 ? 1 : 2);
        f32x4 acc[8];
#pragma unroll
        for (int j = 0; j < 8; ++j) acc[j] = (f32x4){0.f, 0.f, 0.f, 0.f};
        const bf16* ap0 = A + (size_t)(rb * 16 + fr) * KLORA + k0 + fq * 8;
        const bf16* bp0 = Wl + (size_t)(blk * 1024 + cg * 128 + fr) * KLORA + k0 + fq * 8;
        for (int ks = 0; ks < nk; ++ks) {
            const bf16x8 af = *(const bf16x8*)(ap0 + ks * 32);
#pragma unroll
            for (int j = 0; j < 8; ++j) { const bf16x8 bf = *(const bf16x8*)(bp0 + (size_t)j * 16 * KLORA + ks * 32); acc[j] = MFMA16(bf, af, acc[j]); }
        }
        const float* bias = blk == 0 ? ap->in[I_DW0] + (size_t)l * RW : (blk == 1 ? ap->in[I_A0] + (size_t)l * RW : ap->in[I_VV0]);
        float* dstf = (float*)(ws + (blk == 0 ? WS_WDEC : (blk == 1 ? WS_ASIG : WS_VG))); bf16* dstb = (bf16*)(ws + WS_G);
        const size_t roff = (size_t)(rb * 16 + fr) * RW;
#pragma unroll
        for (int j = 0; j < 8; ++j) { const int col = cg * 128 + j * 16 + fq * 4; f32x4 v = acc[j];
            if (blk == 2) { u32x2 w; w.x = cvt_pk_bf16(v[0], v[1]); w.y = cvt_pk_bf16(v[2], v[3]); *(u32x2*)(dstb + roff + col) = w; }
            else { v = v + *(const f32x4*)(bias + col);
                if (blk == 0) {
#pragma unroll
                    for (int e = 0; e < 4; ++e) { const float z = -v[e]; const float sp = fmaxf(z, 0.f) + __logf(1.0f + __expf(-fabsf(z))); v[e] = __expf(-__expf(-sp - 0.5f)); } }
                else {
#pragma unroll
                    for (int e = 0; e < 4; ++e) v[e] = sigmoidf_(v[e]); }
                *(f32x4*)(dstf + roff + col) = v; } }
    }
}

template <class Epi> __device__ __forceinline__ void run_gemm(const Ctx& C, const bf16* A, const bf16* Bt, int M, int N, int K, const Epi& E) {
#ifdef ZERO_LDS
    for (int i = C.tid; i < 131072 / 16; i += 512) *(LAS u32x4*)(C.lds + i * 16) = (u32x4){0u, 0u, 0u, 0u};
    __syncthreads();
#endif
    pg8::Gemm g{A, Bt, M, N, K}; pg8::StaticOrder S; S.init(M, N, C.G, (int)C.bx);
    pg8::gemm_phase<Epi, pg8::StaticOrder, GEMM_ALIGN, GEMM_SP2>(C.lds, g, S, E, C.tid);
}

__device__ __forceinline__ Ctx make_ctx(unsigned char* lds_raw, int wave0) {
    Ctx C; int ln; asm volatile("v_mbcnt_lo_u32_b32 %0, -1, 0\n\tv_mbcnt_hi_u32_b32 %0, -1, %0" : "=v"(ln)); int t = wave0 * 64 + ln; int bx = blockIdx.x; asm volatile("" : "+s"(bx));
    C.lds = (LAS unsigned char*)lds_raw; C.tid = t; C.lane = t & 63; C.wave = __builtin_amdgcn_readfirstlane(t >> 6);
    C.G = gridDim.x; C.bx = bx; C.gw = bx * 8 + C.wave; C.NGW = C.G * 8; return C;
}

#define XB_TMO      128
#define XB_XCNT(j)  (256  + 64 * (j))
#define XB_XSUB(j)  (1280 + 64 * (j))
#define XB_XGEN(j)  (2304 + 64 * (j))
#define XB_TOP      3328
#define XB_TOPGEN   3392
#define XCD_BAR_WORDS 3456
#define XB_SPIN_CAP (1u << 18)

__device__ __forceinline__ unsigned xb_ld(unsigned* p)              { return __hip_atomic_load(p, __ATOMIC_RELAXED, __HIP_MEMORY_SCOPE_AGENT); }
__device__ __forceinline__ unsigned xb_add(unsigned* p, unsigned v) { return __hip_atomic_fetch_add(p, v, __ATOMIC_RELAXED, __HIP_MEMORY_SCOPE_AGENT); }
__device__ __forceinline__ unsigned xb_xcc_id() { return (unsigned)__builtin_amdgcn_s_getreg((3 << 11) | 20) & 0xFu; }
#define XB_SPIN(cond, bar) do { unsigned _sp = 0; while (cond) { __builtin_amdgcn_s_sleep(1); \
    if ((++_sp & 255u) == 0u) { if (xb_ld(&(bar)[XB_TMO])) break; if (_sp > XB_SPIN_CAP) { atomicAdd(&(bar)[XB_TMO], 1u); break; } } } } while (0)

struct XcdBarrier {
    unsigned* bar; unsigned x;
    volatile LAS unsigned* st;
};

__device__ __forceinline__ XcdBarrier xcd_barrier_post(unsigned* bar, volatile LAS unsigned* st) {
    XcdBarrier b; b.bar = bar; b.x = xb_xcc_id(); b.st = st;
    if (threadIdx.x == 0) (void)xb_add(&bar[XB_XCNT(b.x)], 1u);
    return b;
}
__device__ __forceinline__ void xcd_barrier_complete(unsigned* bar, unsigned x, unsigned& nloc, unsigned& nx) {
    const unsigned G = gridDim.x * gridDim.y * gridDim.z;
    unsigned sum, cnt, mine, sp = 0u;
    for (;;) {
        sum = 0u; cnt = 0u; mine = 0u;
#pragma unroll
        for (unsigned j = 0; j < 16; ++j) { const unsigned c = xb_ld(&bar[XB_XCNT(j)]); sum += c; cnt += (c > 0u) ? 1u : 0u; mine = (j == x) ? c : mine; }
        if (sum == G) break;
        __builtin_amdgcn_s_sleep(1);
        if ((++sp & 255u) == 0u) { if (xb_ld(&bar[XB_TMO])) break; if (sp > XB_SPIN_CAP) { atomicAdd(&bar[XB_TMO], 1u); break; } }
    }
    nloc = mine > 0u ? mine : 1u; nx = cnt > 0u ? cnt : 1u;
}

__device__ __forceinline__ void xcd_barrier(const XcdBarrier& b) {
    asm volatile("s_waitcnt vmcnt(0)" ::: "memory");
    __syncthreads();
    if (threadIdx.x == 0) {
        unsigned* bar = b.bar;
        __builtin_amdgcn_s_waitcnt(0);
        unsigned nloc = b.st[0], nx = b.st[1];
        if (nloc == 0u) { xcd_barrier_complete(bar, b.x, nloc, nx); b.st[0] = nloc; b.st[1] = nx; }
        const unsigned old = xb_add(&bar[XB_XSUB(b.x)], 1u);
        const unsigned gen = old / nloc;
        if (old + 1u == (gen + 1u) * nloc) {
            __builtin_amdgcn_fence(__ATOMIC_RELEASE, "agent");
            asm volatile("s_waitcnt vmcnt(0)" ::: "memory");
            const unsigned og = xb_add(&bar[XB_TOP], 1u);
            const unsigned tg = og / nx;
            if (og + 1u == (tg + 1u) * nx) xb_add(&bar[XB_TOPGEN], 1u);
            else XB_SPIN(xb_ld(&bar[XB_TOPGEN]) == tg, bar);
            __builtin_amdgcn_fence(__ATOMIC_ACQUIRE, "agent");
            xb_add(&bar[XB_XGEN(b.x)], 1u);
            asm volatile("s_waitcnt vmcnt(0)" ::: "memory");
        } else {
            XB_SPIN(xb_ld(&bar[XB_XGEN(b.x)]) == gen, bar);
            __builtin_amdgcn_fence(__ATOMIC_ACQUIRE, "agent");
            asm volatile("s_waitcnt vmcnt(0)" ::: "memory");
        }
    }
    __syncthreads();
}

#define XB_WS_WORD 1024
#define XB_LDS_OFF 147392
__device__ __forceinline__ void xcd_sync(unsigned char* lds_raw) {
    XcdBarrier b; b.bar = (unsigned*)get_args()->ws + XB_WS_WORD; b.x = xb_xcc_id(); b.st = (volatile LAS unsigned*)(lds_raw + XB_LDS_OFF);
    xcd_barrier(b);
}
__device__ __forceinline__ void grid_barrier(unsigned* bar, unsigned target) {
    asm volatile("s_waitcnt vmcnt(0) lgkmcnt(0)" ::: "memory");
    __syncthreads();
    if (threadIdx.x == 0) {
        __builtin_amdgcn_fence(__ATOMIC_RELEASE, "agent");
        asm volatile("s_waitcnt vmcnt(0)" ::: "memory");
        __hip_atomic_fetch_add(bar, 1u, __ATOMIC_RELAXED, __HIP_MEMORY_SCOPE_AGENT);
        while (__hip_atomic_load(bar, __ATOMIC_RELAXED, __HIP_MEMORY_SCOPE_AGENT) < target) __builtin_amdgcn_s_sleep(2);
#ifdef BAR_DELAY
        { const unsigned long long t0 = __builtin_amdgcn_s_memrealtime(); while (__builtin_amdgcn_s_memrealtime() - t0 < 5000ull) __builtin_amdgcn_s_sleep(8); }
#endif
        __builtin_amdgcn_fence(__ATOMIC_ACQUIRE, "agent");
        asm volatile("s_waitcnt vmcnt(0)" ::: "memory");
    }
    __syncthreads();
}

#ifdef STOPK
__device__ __forceinline__ void dump_u32(float* out, const unsigned char* srcb, size_t nwords, bool first) {
    const unsigned* src = (const unsigned*)srcb;
    for (size_t i = (size_t)blockIdx.x * 512 + threadIdx.x; i < (size_t)MROWS * DM; i += (size_t)gridDim.x * 512) {
        const unsigned w = src[i % nwords]; const unsigned hh = (w ^ (w >> 15)) * 2654435761u; const float v = (float)((hh ^ (hh >> 13)) * 2246822519u >> 8) * (1.0f / 16777216.0f);
        out[i] = first ? v : out[i] + v; }
}
#ifndef STOPL
#define STOPL 1
#endif
#define STOP_AT(k, ...) if (l == STOPL && STOPK == (k)) { CArgs* ap = get_args(); unsigned char* ws = ap->ws; float* out = ap->out; __VA_ARGS__; return; }
#else
#define STOP_AT(k, ...)
#endif

#ifdef STOPK
__device__ __forceinline__ void sum_region(const unsigned char* srcb, size_t ld, size_t w0, size_t nw, size_t nrows, unsigned* acc) {
    const unsigned* src = (const unsigned*)srcb; unsigned part = 0u;
    for (size_t i = (size_t)blockIdx.x * 512 + threadIdx.x; i < nw * nrows; i += (size_t)gridDim.x * 512) {
        const size_t r = i / nw, c = i % nw; const unsigned w = src[r * ld + w0 + c]; const unsigned hh = (w ^ (w >> 15)) * 2654435761u + (unsigned)i * 40503u; part += (hh ^ (hh >> 13)) * 2246822519u; }
    atomicAdd(acc, part);
}
__device__ __forceinline__ void bcast_sum(float* out, unsigned* acc, unsigned target) {
    grid_barrier(acc - 64, target);
    const unsigned tot = __hip_atomic_load(acc, __ATOMIC_RELAXED, __HIP_MEMORY_SCOPE_AGENT);
    for (size_t i = (size_t)blockIdx.x * 512 + threadIdx.x; i < (size_t)MROWS * DM; i += (size_t)gridDim.x * 512) {
        const unsigned hh = (tot + (unsigned)i) * 2654435761u; out[i] = (float)((hh ^ (hh >> 13)) * 2246822519u >> 8) * (1.0f / 16777216.0f); }
}
#define ANYBIT(k, ...) if (l == STOPL && STOPK == (k)) { CArgs* ap = get_args(); unsigned char* ws = ap->ws; unsigned* acc = (unsigned*)ws + 64; __VA_ARGS__; bcast_sum(ap->out, acc, (unsigned)(++bar_idx) * gridDim.x); return; }
#else
#define ANYBIT(k, ...)
#endif
#define PH_BEGIN if (pidx >= ph_lo && pidx < ph_hi) { CArgs* ap = get_args(); unsigned char* ws = ap->ws; (void)ws; const Ctx C = make_ctx(lds_raw, wave0);
#define PH_END } if (pidx >= ph_lo && pidx + 1 < ph_hi) xcd_sync(lds_raw); ++pidx;
#define WSB(off) ((bf16*)(ws + (off)))
#define WSF(off) ((float*)(ws + (off)))
template <int l> __device__ __forceinline__ void layer_body(unsigned char* lds_raw, const int wave0, int& bar_idx, int& pidx, const int ph_lo, const int ph_hi) {
        PH_BEGIN run_gemm(C, WSB(WS_XN), WSB(WS_WGU1), MROWS, 2 * FF, DM, EpiSwiglu{WSB(WS_ACT)});
                 if (l == 0) {
                     const int nb = ((MROWS / 256) * (2 * FF / 256)) % C.G;
                     if (nb == 0) convert_phase(C, 0, 8);
                     else if (C.bx >= nb) { Ctx Cc = C; Cc.bx = C.bx - nb; Cc.G = C.G - nb; Cc.gw = Cc.bx * 8 + C.wave; Cc.NGW = Cc.G * 8; convert_phase(Cc, 0, 8); }
                 } PH_END
        STOP_AT(1, dump_u32(out, ws + WS_ACT, (size_t)MROWS * FF / 2, true))
        ANYBIT(101, sum_region(ws + WS_ACT, FF / 2, 0, FF / 2, MROWS, acc))
        PH_BEGIN run_gemm(C, WSB(WS_ACT), WSB(WS_WD1), MROWS, DM, FF, EpiProj{WSB(WS_YF), DM}); PH_END
        STOP_AT(2, dump_u32(out, ws + WS_YF, (size_t)MROWS * DM, true))
        ANYBIT(102, sum_region(ws + WS_YF, DM, 0, DM, MROWS, acc))
        PH_BEGIN if (l == 0) norm_phase<false, true>(C, WSB(WS_YF), ap->in[I_F1POST] + (size_t)l * DM, 0.5f, ap->in[I_X], WSB(824 * MiB), ap->in[I_MIXPRE] + (size_t)l * DM, WSB(WS_XN));
                 else norm_phase<true, true>(C, WSB(WS_YF), ap->in[I_F1POST] + (size_t)l * DM, 0.5f, WSB(824 * MiB), WSB(824 * MiB), ap->in[I_MIXPRE] + (size_t)l * DM, WSB(WS_XN)); PH_END
        STOP_AT(3, dump_u32(out, ws + WS_XN, (size_t)MROWS * DM / 2, true))
        ANYBIT(103, sum_region(ws + WS_XN, DM / 2, 0, DM / 2, MROWS, acc); sum_region((const unsigned char*)ap->out, DM, 0, DM, MROWS, acc))
#ifdef STOP_L1_P3
        if (l == 1) return;
#endif
        PH_BEGIN run_gemm(C, WSB(WS_XN), WSB(WS_WIN), MROWS, NPROJ, DM, EpiProj{WSB(WS_PROJ), NPROJ});
                 if (l == 0) { const int nb = ((MROWS / 256) * (NPROJ / 256)) % C.G;
                     if (nb == 0) convert_phase(C, 0, 16);
                     else if (C.bx >= nb) { Ctx Cc = C; Cc.bx = C.bx - nb; Cc.G = C.G - nb; Cc.gw = Cc.bx * 8 + C.wave; Cc.NGW = Cc.G * 8; convert_phase(Cc, 0, 16); } } PH_END
        STOP_AT(4, dump_u32(out, ws + WS_PROJ, (size_t)MROWS * NPROJ / 2, true))
        ANYBIT(104, sum_region(ws + WS_PROJ, NPROJ / 2, 1536, 160, MROWS, acc))
        ANYBIT(105, sum_region(ws + WS_PROJ, NPROJ / 2, 0, NPROJ / 2, MROWS, acc))
        STOP_AT(41, dump_u32(out, ws + WS_PROJ + 64 * MiB, (size_t)44 * MiB, true); dump_u32(out, ws + WS_PROJ + 176 * MiB, (size_t)16 * MiB, false))
        STOP_AT(42, dump_u32(out, ws + WS_PROJ + 128 * MiB, (size_t)28 * MiB, true))
        STOP_AT(43, dump_u32(out, ws + WS_PROJ + 176 * MiB, (size_t)16 * MiB, true))
#ifdef ONLY_LORAA
        PH_BEGIN loraA_phase(C, l); PH_END
#else
        PH_BEGIN loraA_phase(C, l); PH_END
#endif
        STOP_AT(5, dump_u32(out, ws + WS_ALORA, (size_t)MROWS * KLORA / 2, true))
        ANYBIT(106, sum_region(ws + WS_ALORA, KLORA / 2, 0, KLORA / 2, MROWS, acc))
        ANYBIT(107, sum_region(ws + WS_OATT, 1536, 0, 1536, MROWS, acc); sum_region(ws + WS_LSE, 12, 0, 12, MROWS, acc); sum_region(ws + WS_YSGU, 256, 0, 256, MROWS, acc))
#ifdef SKIP_LORA0
        PH_BEGIN if (l == 1) lora_phase(C, l); PH_END
#else
        PH_BEGIN lora_phase(C, l); PH_END
#endif
        ANYBIT(108, sum_region(ws + WS_WDEC, RW, 0, RW, MROWS, acc); sum_region(ws + WS_ASIG, RW, 0, RW, MROWS, acc); sum_region(ws + WS_G, RW / 2, 0, RW / 2, MROWS, acc); if (l > 0) sum_region(ws + WS_VG, RW, 0, RW, MROWS, acc))
        STOP_AT(6, dump_u32(out, ws + 824 * MiB, (size_t)MROWS * RW / 2, true))
        STOP_AT(62, dump_u32(out, ws + WS_G, (size_t)MROWS * RW / 2, true))
        STOP_AT(61, dump_u32(out, ws + WS_WDEC, (size_t)MROWS * RW, true); dump_u32(out, ws + WS_ASIG, (size_t)MROWS * RW, false); dump_u32(out, ws + WS_VG, (size_t)MROWS * RW, false))
        PH_BEGIN prep_phase(C, l); PH_END
        ANYBIT(109, sum_region(ws + WS_R, RW, 0, RW, MROWS, acc); sum_region(ws + WS_K, RW, 0, RW, MROWS, acc); sum_region(ws + WS_KK, RW, 0, RW, MROWS, acc); sum_region(ws + WS_BV, RW, 0, RW, MROWS, acc); sum_region(ws + WS_VFIRST, RW, 0, RW, MROWS, acc))
        STOP_AT(7, dump_u32(out, ws + WS_R, (size_t)MROWS * RW, true); dump_u32(out, ws + WS_K, (size_t)MROWS * RW, false); dump_u32(out, ws + WS_KK, (size_t)MROWS * RW, false); dump_u32(out, ws + WS_BV, (size_t)MROWS * RW, false); dump_u32(out, ws + WS_VFIRST, (size_t)MROWS * RW, false))
        PH_BEGIN scan_phase(C, l, l == 0 ? 2 : 18, 1, l == 0 ? 12 : 0, l); PH_END
        ANYBIT(110, sum_region(ws + WS_YS, RW, 0, RW, MROWS, acc))
        STOP_AT(8, dump_u32(out, ws + WS_YS, (size_t)MROWS * RW, true))
        PH_BEGIN post_phase(C, l); PH_END
        ANYBIT(111, sum_region(ws + WS_YRWKV, RW / 2, 0, RW / 2, MROWS, acc); sum_region(ws + WS_YATT, 256, 0, 256, MROWS, acc))
        STOP_AT(9, dump_u32(out, ws + WS_YRWKV, (size_t)MROWS * RW / 2, true); dump_u32(out, ws + WS_YATT, (size_t)MROWS * 512 / 2, false))
        if (pidx >= ph_lo && pidx < ph_hi) { { CArgs* ap = get_args(); unsigned char* ws = ap->ws; const Ctx C = make_ctx(lds_raw, wave0); run_gemm(C, WSB(WS_YRWKV), WSB(WS_WBR_R), MROWS, DM, RW, EpiMerge<0>{WSB(WS_MERGED_F32), WSB(WS_MERGED_BF), WSB(WS_PROJ) + PC_GATE}); }
          { CArgs* ap = get_args(); unsigned char* ws = ap->ws; const Ctx C = make_ctx(lds_raw, wave0); run_gemm(C, WSB(WS_YATT), WSB(WS_WBR_A), MROWS, DM, 512, EpiMerge<1>{WSB(WS_MERGED_F32), WSB(WS_MERGED_BF), WSB(WS_PROJ) + PC_GATE + 2048}); }
          { CArgs* ap = get_args(); unsigned char* ws = ap->ws; const Ctx C = make_ctx(lds_raw, wave0); run_gemm(C, WSB(WS_YSGU), WSB(WS_WBR_S), MROWS, DM, 512, EpiMerge<2>{WSB(WS_MERGED_F32), WSB(WS_MERGED_BF), WSB(WS_PROJ) + PC_GATE + 4096}); } }
        if (pidx >= ph_lo && pidx + 1 < ph_hi) xcd_sync(lds_raw); ++pidx;
        ANYBIT(112, sum_region(ws + WS_MERGED_BF, DM / 2, 0, DM / 2, MROWS, acc))
        PH_BEGIN run_gemm(C, WSB(WS_MERGED_BF), WSB(WS_WOUT), MROWS, DM, DM, EpiProj{WSB(WS_Y), DM}); PH_END
        STOP_AT(11, dump_u32(out, ws + WS_Y, (size_t)MROWS * DM, true))
        ANYBIT(113, sum_region(ws + WS_Y, DM, 0, DM, MROWS, acc))
        PH_BEGIN norm_phase<true, true>(C, WSB(WS_Y), ap->in[I_MIXPOST] + (size_t)l * DM, 1.0f, WSB(824 * MiB), WSB(824 * MiB), ap->in[I_F2PRE] + (size_t)l * DM, WSB(WS_XN)); PH_END
        ANYBIT(114, sum_region(ws + WS_XN, DM / 2, 0, DM / 2, MROWS, acc); sum_region((const unsigned char*)ap->out, DM, 0, DM, MROWS, acc))
#ifdef STOP_L1_P12
        if (l == 1) return;
#endif
        PH_BEGIN run_gemm(C, WSB(WS_XN), WSB(WS_WGU2), MROWS, 2 * FF, DM, EpiSwiglu{WSB(WS_ACT)});
                 if (l == 0) { const int nb = ((MROWS / 256) * (2 * FF / 256)) % C.G;
                     if (nb == 0) convert_phase(C, 1, 1);
                     else if (C.bx >= nb) { Ctx Cc = C; Cc.bx = C.bx - nb; Cc.G = C.G - nb; Cc.gw = Cc.bx * 8 + C.wave; Cc.NGW = Cc.G * 8; convert_phase(Cc, 1, 1); } } PH_END
        PH_BEGIN run_gemm(C, WSB(WS_ACT), WSB(WS_WD2), MROWS, DM, FF, EpiProj{WSB(WS_YF), DM}); PH_END
        PH_BEGIN if (l == 0) norm_phase<true, true>(C, WSB(WS_YF), ap->in[I_F2POST] + (size_t)l * DM, 0.5f, WSB(824 * MiB), WSB(824 * MiB), ap->in[I_F1PRE] + DM, WSB(WS_XN));
                 else norm_phase<true, false>(C, WSB(WS_YF), ap->in[I_F2POST] + (size_t)l * DM, 0.5f, WSB(824 * MiB), ap->out, (const float*)nullptr, WSB(WS_XN)); PH_END
}

__global__ void __launch_bounds__(512, 2) mega(Args a_) {
    extern __shared__ __attribute__((aligned(16))) unsigned char lds_raw[];
    cg::grid_group grid = cg::this_grid();
    const int wave0 = __builtin_amdgcn_readfirstlane((int)threadIdx.x >> 6);
    int bar_idx = 0, pidx = 0; const int ph_lo = a_.ph_lo, ph_hi = a_.ph_hi;
    grid.sync();
    if (threadIdx.x < 16) ((LAS unsigned*)(lds_raw + XB_LDS_OFF))[threadIdx.x] = 0u;
    __syncthreads();
    (void)xcd_barrier_post((unsigned*)get_args()->ws + XB_WS_WORD, (volatile LAS unsigned*)(lds_raw + XB_LDS_OFF));
    PH_BEGIN convert_phase(C, 0, 5); prenorm_phase(C, ap->in[I_X], ap->in[I_F1PRE], WSB(WS_XN)); PH_END
#if defined(STOPK) && STOPK == 100
    { CArgs* ap = get_args(); unsigned char* ws = ap->ws; unsigned* acc = (unsigned*)ws + 64; sum_region(ws + WS_XN, DM / 2, 0, DM / 2, MROWS, acc); sum_region(ws + MiB, 1, 0, 1, (size_t)208 * MiB / 4, acc); bcast_sum(ap->out, acc, (unsigned)(++bar_idx) * gridDim.x); return; }
#endif
#if defined(STOPK) && STOPK == 0
    { CArgs* ap = get_args(); dump_u32(ap->out, ap->ws + WS_XN, (size_t)MROWS * DM / 2, true); return; }
#endif
#if defined(STOPK) && STOPK == 51
    { CArgs* ap = get_args(); dump_u32(ap->out, ap->ws + WS_WGU1, (size_t)2 * FF * DM / 2, true); return; }
#endif
#if defined(STOPK) && STOPK == 50
    { CArgs* ap = get_args(); dump_u32(ap->out, (const unsigned char*)ap->in[I_X], (size_t)MROWS * DM, true); return; }
#endif
    layer_body<0>(lds_raw, wave0, bar_idx, pidx, ph_lo, ph_hi);
#if !defined(STOP_L0) && !(defined(STOPK) && defined(STOPL) && STOPL == 0)
    layer_body<1>(lds_raw, wave0, bar_idx, pidx, ph_lo, ph_hi);
#endif
#ifdef DUMP_INPUTS
    { grid_barrier((unsigned*)get_args()->ws, (unsigned)(++bar_idx) * gridDim.x); CArgs* ap = get_args();
      dump_u32(ap->out, (const unsigned char*)ap->in[I_SHMU], 6720, true); dump_u32(ap->out, (const unsigned char*)ap->in[I_VMU], 32, false); dump_u32(ap->out, (const unsigned char*)ap->in[I_VV0], 1024, false); dump_u32(ap->out, (const unsigned char*)ap->in[I_VW2], 32768, false); }
#endif
}

extern "C" void kernel_launch(void* const* d_in, const int* in_sizes, int n_in, void* d_out, int out_size, void* d_ws, size_t ws_size, hipStream_t stream) {
    static int grid = 0;
    if (!grid) {
        int dev = 0, cus = 0, per_cu = 0;
        (void)hipGetDevice(&dev);
        (void)hipDeviceGetAttribute(&cus, hipDeviceAttributeMultiprocessorCount, dev);
        (void)hipFuncSetAttribute((const void*)mega, hipFuncAttributeMaxDynamicSharedMemorySize, LDS_BYTES);
        (void)hipOccupancyMaxActiveBlocksPerMultiprocessor(&per_cu, (const void*)mega, 512, LDS_BYTES);
        if (per_cu < 1) per_cu = 1;
        grid = cus * per_cu;
        if (n_in != N_INPUTS || out_size != MROWS * DM || ws_size < (size_t)856 * MiB) { fprintf(stderr, "kernel_launch: unexpected sizes n_in %d out %d ws %zu\n", n_in, out_size, ws_size); grid = -1; }
    }
    if (grid < 0) return;
    Args a{};
    for (int i = 0; i < N_INPUTS; ++i) a.in[i] = (const float*)d_in[i];
    a.out = (float*)d_out; a.ws = (unsigned char*)d_ws;
#ifndef N_PHASES_PER_LAUNCH
#define N_PHASES_PER_LAUNCH 64
#endif
    constexpr int TOTAL_PH = 31;
    for (int lo = 0; lo < TOTAL_PH; lo += N_PHASES_PER_LAUNCH) {
        (void)hipMemsetAsync(d_ws, 0, 32768, stream);
        a.ph_lo = lo; a.ph_hi = lo + N_PHASES_PER_LAUNCH < TOTAL_PH ? lo + N_PHASES_PER_LAUNCH : TOTAL_PH;
        void* args[] = {&a};
        hipError_t e = hipLaunchCooperativeKernel((void*)mega, dim3(grid), dim3(512), args, LDS_BYTES, stream);
        if (e != hipSuccess) { fprintf(stderr, "cooperative launch failed: %s (grid %d)\n", hipGetErrorString(e), grid); break; }
    }
}
```
